# Optimizing an MI355X kernel written in HIP

```python
import math
import jax, jax.numpy as jnp
from jax import lax
import numpy as np

D_MODEL = 1024
BATCH = 8
SEQ = 2048
DEPTH = 4

N_MIXERS = 2
RMS_EPS = 1e-6
GN_EPS = 1e-6
NEG_INF = -1e30

NSA_HEADS = 16
NSA_HEAD_DIM = 64
NSA_KV_GROUPS = 4
NSA_Q_PER_GROUP = NSA_HEADS // NSA_KV_GROUPS
NSA_WIDTH = NSA_HEADS * NSA_HEAD_DIM
NSA_KV_WIDTH = NSA_KV_GROUPS * NSA_HEAD_DIM
CMP_BLOCK = 32
CMP_STRIDE = 16
CMP_HIDDEN = 256
SLC_BLOCK = 64
SLC_TOPN = 16
SLC_Q_BLOCK = 32
WIN_SIZE = 512
WIN_Q_BLOCK = 128
FORCED_SCORE = 1e3
NSA_PROJ = NSA_WIDTH + 6 * NSA_KV_WIDTH + 3 * NSA_HEADS + 3 * NSA_WIDTH

REL_BUCKETS = 32
REL_MAX_DIST = 128

RET_HEADS = 4
RET_QK_DIM = 256
RET_V_DIM = 512
RET_QK_WIDTH = RET_HEADS * RET_QK_DIM
RET_WIDTH = RET_HEADS * RET_V_DIM
RET_CHUNK = 128
ROPE_BASE = 10000.0
RET_PROJ = 2 * RET_QK_WIDTH + 2 * RET_WIDTH

kernel_name = "hybrid_nsa_retention_sandwich"


def rms_norm(x, gain):
    xf = x.astype(jnp.float32)
    y = xf * lax.rsqrt(jnp.mean(xf * xf, axis=-1, keepdims=True) + RMS_EPS)
    return (y * gain.astype(jnp.float32)).astype(x.dtype)


def split_cols(a, sizes):
    return jnp.split(a, list(np.cumsum(sizes)[:-1]), axis=-1)


def masked_softmax(logits, mask):
    p = jax.nn.softmax(jnp.where(mask, logits, NEG_INF), axis=-1)
    return jnp.where(mask, p, 0.0)


def t5_bucket(dist):
    n = jnp.maximum(dist, 0)
    max_exact = REL_BUCKETS // 2
    nf = jnp.maximum(n, 1).astype(jnp.float32)
    large = max_exact + (jnp.log(nf / max_exact) / math.log(REL_MAX_DIST / max_exact)
                         * (REL_BUCKETS - max_exact)).astype(jnp.int32)
    large = jnp.minimum(large, REL_BUCKETS - 1)
    return jnp.where(n < max_exact, n, large)


def compress_kv(kv, pos, w1, w2):
    B, S, G, dh = kv.shape
    n_cmp = (S - CMP_BLOCK) // CMP_STRIDE + 1
    idx = jnp.arange(n_cmp)[:, None] * CMP_STRIDE + jnp.arange(CMP_BLOCK)[None, :]
    blocks = kv[:, idx] + pos[None, None, :, None, :].astype(kv.dtype)
    flat = blocks.transpose(0, 1, 3, 2, 4).reshape(B, n_cmp, G, CMP_BLOCK * dh)
    return jax.nn.silu(flat @ w1) @ w2


def nsa_compressed(q, kc, vc, table):
    B, S, H, dh = q.shape
    n_cmp = kc.shape[1]
    qg = q.reshape(B, S, NSA_KV_GROUPS, NSA_Q_PER_GROUP, dh)
    logits = jnp.einsum('bsgrd,bcgd->bgrsc', qg, kc).astype(jnp.float32) * (dh ** -0.5)
    t = jnp.arange(S)
    end = jnp.arange(n_cmp) * CMP_STRIDE + CMP_BLOCK - 1
    dist = t[:, None] - end[None, :]
    bias = table[t5_bucket(dist)].astype(jnp.float32)
    bias = bias.reshape(S, n_cmp, NSA_KV_GROUPS, NSA_Q_PER_GROUP).transpose(2, 3, 0, 1)
    p = masked_softmax(logits + bias, dist >= 0)
    o = jnp.einsum('bgrsc,bcgd->bsgrd', p.astype(vc.dtype), vc).reshape(B, S, H, dh)
    return o, p


def select_blocks(p_cmp, S):
    n_cmp = p_cmp.shape[-1]
    n_sel = S // SLC_BLOCK
    cs = jnp.arange(n_cmp) * CMP_STRIDE
    j = jnp.arange(n_sel)
    overlap = ((cs[:, None] < (j[None, :] + 1) * SLC_BLOCK)
               & (cs[:, None] + CMP_BLOCK > j[None, :] * SLC_BLOCK)).astype(jnp.float32)
    imp = jnp.einsum('bgrsc,cj->bgsj', p_cmp, overlap)
    t = jnp.arange(S)
    cur = t // SLC_BLOCK
    valid = j[None, :] * SLC_BLOCK <= t[:, None]
    forced = (j[None, :] == 0) | (j[None, :] == cur[:, None]) | (j[None, :] == cur[:, None] - 1)
    score = jnp.where(valid, imp + jnp.where(forced, FORCED_SCORE, 0.0), NEG_INF)
    _, sel = lax.top_k(score, min(SLC_TOPN, n_sel))
    return sel


def nsa_selected(q, k, v, sel, table):
    B, S, H, dh = q.shape
    G, R = NSA_KV_GROUPS, NSA_Q_PER_GROUP
    n_sel = S // SLC_BLOCK
    n_top = sel.shape[-1]
    n_keys = n_top * SLC_BLOCK
    kb = k.reshape(B, n_sel, SLC_BLOCK, G, dh).transpose(0, 3, 1, 2, 4)
    vb = v.reshape(B, n_sel, SLC_BLOCK, G, dh).transpose(0, 3, 1, 2, 4)
    nq = S // SLC_Q_BLOCK
    q_blk = q.reshape(B, nq, SLC_Q_BLOCK, G, R, dh).transpose(1, 0, 2, 3, 4, 5)
    sel_blk = sel.reshape(B, G, nq, SLC_Q_BLOCK, n_top).transpose(2, 0, 1, 3, 4)
    bi = jnp.arange(B)[:, None, None, None]
    gi = jnp.arange(G)[None, :, None, None]
    tbl = table.reshape(REL_BUCKETS, G, R)

    def one(args):
        qb, sb, blk = args
        t = blk * SLC_Q_BLOCK + jnp.arange(SLC_Q_BLOCK)
        kg = kb[bi, gi, sb].reshape(B, G, SLC_Q_BLOCK, n_keys, dh)
        vg = vb[bi, gi, sb].reshape(B, G, SLC_Q_BLOCK, n_keys, dh)
        pos = (sb[..., None] * SLC_BLOCK + jnp.arange(SLC_BLOCK)).reshape(B, G, SLC_Q_BLOCK, n_keys)
        dist = t[None, None, :, None] - pos
        bias = tbl[t5_bucket(dist), gi].astype(jnp.float32).transpose(0, 1, 4, 2, 3)
        logits = jnp.einsum('bqgrd,bgqkd->bgrqk', qb, kg).astype(jnp.float32) * (dh ** -0.5)
        p = masked_softmax(logits + bias, (dist >= 0)[:, :, None])
        return jnp.einsum('bgrqk,bgqkd->bqgrd', p.astype(vg.dtype), vg)

    out = lax.map(one, (q_blk, sel_blk, jnp.arange(nq)))
    return out.transpose(1, 0, 2, 3, 4, 5).reshape(B, S, H, dh)


def nsa_window(q, k, v, table):
    B, S, H, dh = q.shape
    G, R = NSA_KV_GROUPS, NSA_Q_PER_GROUP
    nq = S // WIN_Q_BLOCK
    span = WIN_SIZE + WIN_Q_BLOCK
    kp = jnp.pad(k, ((0, 0), (WIN_SIZE, 0), (0, 0), (0, 0)))
    vp = jnp.pad(v, ((0, 0), (WIN_SIZE, 0), (0, 0), (0, 0)))
    q_blk = q.reshape(B, nq, WIN_Q_BLOCK, G, R, dh).transpose(1, 0, 2, 3, 4, 5)

    def one(args):
        qb, blk = args
        start = blk * WIN_Q_BLOCK
        kw = lax.dynamic_slice_in_dim(kp, start, span, axis=1)
        vw = lax.dynamic_slice_in_dim(vp, start, span, axis=1)
        t = start + jnp.arange(WIN_Q_BLOCK)
        pos = start - WIN_SIZE + jnp.arange(span)
        dist = t[:, None] - pos[None, :]
        mask = (dist >= 0) & (dist < WIN_SIZE) & (pos[None, :] >= 0)
        bias = table[t5_bucket(dist)].astype(jnp.float32)
        bias = bias.reshape(WIN_Q_BLOCK, span, G, R).transpose(2, 3, 0, 1)
        logits = jnp.einsum('bqgrd,bkgd->bgrqk', qb, kw).astype(jnp.float32) * (dh ** -0.5)
        p = masked_softmax(logits + bias, mask)
        return jnp.einsum('bgrqk,bkgd->bqgrd', p.astype(vw.dtype), vw)

    out = lax.map(one, (q_blk, jnp.arange(nq)))
    return out.transpose(1, 0, 2, 3, 4, 5).reshape(B, S, H, dh)


def nsa_mixer(h, w_in, w_out, k_pos, k_w1, k_w2, v_pos, v_w1, v_w2, table):
    B, S, _ = h.shape
    H, dh, G = NSA_HEADS, NSA_HEAD_DIM, NSA_KV_GROUPS
    q, kv, g, z = split_cols(h @ w_in, [NSA_WIDTH, 6 * NSA_KV_WIDTH, 3 * H, 3 * NSA_WIDTH])
    q = q.reshape(B, S, H, dh)
    k_c, v_c, k_s, v_s, k_w, v_w = [a.reshape(B, S, G, dh) for a in jnp.split(kv, 6, axis=-1)]
    gates = jax.nn.sigmoid(g).reshape(B, S, 3, H, 1)
    zs = jax.nn.silu(z).reshape(B, S, 3, H, dh)
    kc = compress_kv(k_c, k_pos, k_w1, k_w2)
    vc = compress_kv(v_c, v_pos, v_w1, v_w2)
    o_cmp, p_cmp = nsa_compressed(q, kc, vc, table)
    sel = select_blocks(p_cmp, S)
    o_slc = nsa_selected(q, k_s, v_s, sel, table)
    o_win = nsa_window(q, k_w, v_w, table)
    o = jnp.stack([o_cmp, o_slc, o_win], axis=2)
    y = jnp.sum(gates * o * zs, axis=2).reshape(B, S, NSA_WIDTH)
    return y @ w_out


def rotary(x):
    S, d = x.shape[1], x.shape[-1]
    inv = 1.0 / (ROPE_BASE ** jnp.linspace(0.0, 1.0, d // 2, dtype=jnp.float32))
    ang = jnp.arange(S, dtype=jnp.float32)[:, None] * inv[None, :]
    cos = jnp.cos(ang)[None, :, None, :].astype(x.dtype)
    sin = jnp.sin(ang)[None, :, None, :].astype(x.dtype)
    x1, x2 = x[..., :d // 2], x[..., d // 2:]
    return jnp.concatenate([x1 * cos - x2 * sin, x1 * sin + x2 * cos], axis=-1)


def chunkwise_retention(q, k, v):
    B, S, H, dk = q.shape
    dv = v.shape[-1]
    C = RET_CHUNK
    nc = S // C
    dt = q.dtype
    log_g = jnp.log(1.0 - 2.0 ** (-5.0 - jnp.arange(H, dtype=jnp.float32)))
    i = jnp.arange(C, dtype=jnp.float32)
    diff = i[:, None] - i[None, :]
    inner = jnp.where(diff >= 0, jnp.exp(diff[None] * log_g[:, None, None]), 0.0).astype(dt)
    xi = jnp.exp((i + 1.0)[None, :] * log_g[:, None]).astype(dt)
    zeta = jnp.exp((C - 1.0 - i)[None, :] * log_g[:, None]).astype(dt)
    chunk_decay = jnp.exp(C * log_g).astype(dt)
    qc = q.reshape(B, nc, C, H, dk).transpose(1, 0, 3, 2, 4)
    kc = k.reshape(B, nc, C, H, dk).transpose(1, 0, 3, 2, 4)
    vc = v.reshape(B, nc, C, H, dv).transpose(1, 0, 3, 2, 4)

    def step(state, inp):
        qi, ki, vi = inp
        attn = jnp.einsum('bhid,bhjd->bhij', qi, ki) * inner[None]
        o = (jnp.einsum('bhij,bhjv->bhiv', attn, vi)
             + jnp.einsum('bhid,bhdv->bhiv', qi, state) * xi[None, :, :, None])
        state = (state * chunk_decay[None, :, None, None]
                 + jnp.einsum('bhjd,bhjv->bhdv', ki * zeta[None, :, :, None], vi))
        return state, o

    state0 = jnp.zeros((B, H, dk, dv), dt)
    _, o = lax.scan(step, state0, (qc, kc, vc))
    return o.transpose(1, 0, 3, 2, 4).reshape(B, S, H, dv)


def retention_mixer(h, w_in, w_out, gn_gain):
    B, S, _ = h.shape
    q, k, v, z = split_cols(h @ w_in, [RET_QK_WIDTH, RET_QK_WIDTH, RET_WIDTH, RET_WIDTH])
    q = rotary(q.reshape(B, S, RET_HEADS, RET_QK_DIM))
    k = rotary(k.reshape(B, S, RET_HEADS, RET_QK_DIM)) * (RET_QK_DIM ** -0.5)
    v = v.reshape(B, S, RET_HEADS, RET_V_DIM)
    o = chunkwise_retention(q, k, v).astype(jnp.float32)
    mu = jnp.mean(o, axis=-1, keepdims=True)
    var = jnp.mean(jnp.square(o - mu), axis=-1, keepdims=True)
    o = (o - mu) * lax.rsqrt(var + GN_EPS) * gn_gain.reshape(RET_HEADS, RET_V_DIM).astype(jnp.float32)
    o = o.astype(h.dtype).reshape(B, S, RET_WIDTH)
    return (o * jax.nn.silu(z)) @ w_out


def setup_inputs(seed: int = 0) -> dict:
    key = jax.random.key(seed)
    ks = jax.random.split(key, 16)
    n_nsa = (DEPTH + N_MIXERS - 1) // N_MIXERS
    n_ret = DEPTH // N_MIXERS

    def nrm(k, shape, scale):
        return jax.random.normal(k, shape, jnp.float32) * scale

    return {
        "x": nrm(ks[0], (BATCH, SEQ, D_MODEL), 1.0),
        "pre_norm_gain": 1.0 + nrm(ks[1], (DEPTH, D_MODEL), 0.1),
        "post_norm_gain": 1.0 + nrm(ks[2], (DEPTH, D_MODEL), 0.1),
        "rel_bias_table": nrm(ks[3], (REL_BUCKETS, NSA_HEADS), 0.5),
        "nsa_w_in": nrm(ks[4], (n_nsa, D_MODEL, NSA_PROJ), D_MODEL ** -0.5),
        "nsa_w_out": nrm(ks[5], (n_nsa, NSA_WIDTH, D_MODEL), NSA_WIDTH ** -0.5),
        "nsa_cmp_k_pos": nrm(ks[6], (n_nsa, CMP_BLOCK, NSA_HEAD_DIM), 0.5),
        "nsa_cmp_k_w1": nrm(ks[7], (n_nsa, CMP_BLOCK * NSA_HEAD_DIM, CMP_HIDDEN), (CMP_BLOCK * NSA_HEAD_DIM) ** -0.5),
        "nsa_cmp_k_w2": nrm(ks[8], (n_nsa, CMP_HIDDEN, NSA_HEAD_DIM), CMP_HIDDEN ** -0.5),
        "nsa_cmp_v_pos": nrm(ks[9], (n_nsa, CMP_BLOCK, NSA_HEAD_DIM), 0.5),
        "nsa_cmp_v_w1": nrm(ks[10], (n_nsa, CMP_BLOCK * NSA_HEAD_DIM, CMP_HIDDEN), (CMP_BLOCK * NSA_HEAD_DIM) ** -0.5),
        "nsa_cmp_v_w2": nrm(ks[11], (n_nsa, CMP_HIDDEN, NSA_HEAD_DIM), CMP_HIDDEN ** -0.5),
        "ret_w_in": nrm(ks[12], (n_ret, D_MODEL, RET_PROJ), D_MODEL ** -0.5),
        "ret_w_out": nrm(ks[13], (n_ret, RET_WIDTH, D_MODEL), RET_WIDTH ** -0.5),
        "ret_gn_gain": 1.0 + nrm(ks[14], (n_ret, RET_WIDTH), 0.1),
    }


def reference(x, pre_norm_gain, post_norm_gain, rel_bias_table, nsa_w_in, nsa_w_out,
              nsa_cmp_k_pos, nsa_cmp_k_w1, nsa_cmp_k_w2, nsa_cmp_v_pos, nsa_cmp_v_w1, nsa_cmp_v_w2,
              ret_w_in, ret_w_out, ret_gn_gain):
    h = x
    for layer in range(DEPTH):
        slot = layer // N_MIXERS
        u = rms_norm(h, pre_norm_gain[layer])
        if layer % N_MIXERS == 0:
            y = nsa_mixer(u, nsa_w_in[slot], nsa_w_out[slot],
                          nsa_cmp_k_pos[slot], nsa_cmp_k_w1[slot], nsa_cmp_k_w2[slot],
                          nsa_cmp_v_pos[slot], nsa_cmp_v_w1[slot], nsa_cmp_v_w2[slot],
                          rel_bias_table)
        else:
            y = retention_mixer(u, ret_w_in[slot], ret_w_out[slot], ret_gn_gain[slot])
        h = h + rms_norm(y, post_norm_gain[layer])
    return h
```

```cpp
#include <hip/hip_runtime.h>
#include <cstdio>
#include <cstdint>
namespace pg8 {
#define PG8_LAS __attribute__((address_space(3)))
typedef unsigned short bf16_t;
typedef short bf16x8 __attribute__((ext_vector_type(8)));
typedef float f32x4 __attribute__((ext_vector_type(4)));
typedef unsigned u32x4 __attribute__((ext_vector_type(4)));
constexpr int BM = 256, BK = 64, HALF = 128, HTB = HALF * BK * 2  , STAGE_BYTES = 8 * HTB, NXCD = 8, WGM = 8;

__host__ __device__ __forceinline__ int lds_byte(int r, int c) { const int st = (r >> 4) * 2 + (c >> 5), rr = r & 15, cc = c & 31, ob = rr * 64 + cc * 2; return st * 1024 + (ob ^ (((ob >> 9) & 1) << 5)); }
__host__ __device__ __forceinline__ void stage_rc(int b, int& R, int& C) { const int st = b / 1024, sb = b % 1024, swz = sb ^ (((sb >> 9) & 1) << 5); R = (st >> 1) * 16 + swz / 64; C = (st & 1) * 32 + (swz % 64) / 2; }
__host__ __device__ __forceinline__ int perm32(int rho) { const int n = rho >> 4, i = rho & 15; return 8 * (i >> 2) + 4 * n + (i & 3); }

struct Unit { int pm, pn; };
struct Gemm { const bf16_t* A; const bf16_t* Bt; int M, N, K; };

struct StaticOrder {
    int nM, nN, nwg, G, c;
    __host__ __device__ void init(int M, int N, int G_, int c_) { nM = M / BM; nN = N / BM; nwg = nM * nN; G = G_; c = c_; }
    __host__ __device__ bool next(int i, Unit& u) const {
        const long L = (long)i * G + c; if (L >= nwg) return false;
        int wgid = (int)L; { const int q = nwg / NXCD, r = nwg % NXCD, xcd = wgid % NXCD, off = wgid / NXCD; wgid = (xcd < r ? xcd * (q + 1) : r * (q + 1) + (xcd - r) * q) + off; }
        const int nig = WGM * nN, gid = wgid / nig, fm = gid * WGM, gsz = (nM - fm) < WGM ? (nM - fm) : WGM;
        u.pm = fm + ((wgid % nig) % gsz); u.pn = (wgid % nig) / gsz; return true;
    }
    __device__ __forceinline__ void a_ready(const Unit&) const {}
    __device__ __forceinline__ void done(const Unit&) const {}
};

__device__ __forceinline__ unsigned cvt_pk_bf16(float lo, float hi) { unsigned r; asm volatile("v_cvt_pk_bf16_f32 %0, %1, %2" : "=v"(r) : "v"(lo), "v"(hi)); return r; }
typedef float f32x2 __attribute__((ext_vector_type(2)));
__device__ __forceinline__ float silu_f(float x) { return x / (1.0f + __expf(-x)); }
__device__ __forceinline__ float sigm_f(float x) { return 1.0f / (1.0f + __expf(-x)); }
__device__ __forceinline__ u32x4 pack8(const f32x4 a, const f32x4 b) { u32x4 w; w.x = cvt_pk_bf16(a[0], a[1]); w.y = cvt_pk_bf16(a[2], a[3]); w.z = cvt_pk_bf16(b[0], b[1]); w.w = cvt_pk_bf16(b[2], b[3]); return w; }
struct EpiNsaProj {
    static constexpr bool PERM = true, AFTER_DRAIN = false;
    const float* rss; bf16_t* Q; bf16_t* KV; bf16_t* Z; float* GT;
    __device__ __forceinline__ void operator()(const f32x4 (&acc)[2][2][4][2], const Unit& u, int wr, int wc, int fr, int fq) const {
        const int row0 = u.pm * BM + wr * 64 + fr, cl = wc * 32 + 8 * fq, pn = u.pn;
#pragma unroll
        for (int ai = 0; ai < 2; ++ai)
#pragma unroll
            for (int m = 0; m < 4; ++m) {
                const int row = row0 + ai * HALF + m * 16;
                const float rs = rsqrtf(rss[row] * (1.0f / 1024.0f) + 1e-6f);
#pragma unroll
                for (int bj = 0; bj < 2; ++bj) {
                    const int c = bj * HALF + cl;
                    f32x4 v0 = acc[ai][bj][m][0] * rs, v1 = acc[ai][bj][m][1] * rs;
                    if (pn < 4) { *(u32x4*)(Q + (size_t)row * 1024 + pn * 256 + c) = pack8(v0, v1); }
                    else if (pn < 10) { const int j = pn - 4, g = c >> 6, d = c & 63, b = row >> 11, s = row & 2047;
                        *(u32x4*)(KV + (size_t)j * (16384 * 256) + ((size_t)((b * 4 + g) * 2048 + s)) * 64 + d) = pack8(v0, v1); }
                    else if (pn < 22) {
#pragma unroll
                        for (int e = 0; e < 4; ++e) { v0[e] = silu_f(v0[e]); v1[e] = silu_f(v1[e]); }
                        *(u32x4*)(Z + (size_t)row * 3072 + (pn - 10) * 256 + c) = pack8(v0, v1); }
                    else if (c < 48) {
#pragma unroll
                        for (int e = 0; e < 4; ++e) { v0[e] = sigm_f(v0[e]); v1[e] = sigm_f(v1[e]); }
                        *(f32x4*)(GT + (size_t)row * 48 + c) = v0; *(f32x4*)(GT + (size_t)row * 48 + c + 4) = v1; }
                }
            }
    }
};
struct EpiRetProj {
    static constexpr bool PERM = true, AFTER_DRAIN = false;
    const float* rss; const float* COS; const float* SIN; bf16_t* Q; bf16_t* K; bf16_t* V; bf16_t* Z;
    __device__ __forceinline__ void operator()(const f32x4 (&acc)[2][2][4][2], const Unit& u, int wr, int wc, int fr, int fq) const {
        const int row0 = u.pm * BM + wr * 64 + fr, cl = wc * 32 + 8 * fq, pn = u.pn;
#pragma unroll
        for (int ai = 0; ai < 2; ++ai)
#pragma unroll
            for (int m = 0; m < 4; ++m) {
                const int row = row0 + ai * HALF + m * 16;
                const float rs = rsqrtf(rss[row] * (1.0f / 1024.0f) + 1e-6f);
                if (pn < 8) {
                    const float sc = pn < 4 ? rs : rs * 0.0625f;
                    const int s = row & 2047;
                    const f32x4 c0 = *(const f32x4*)(COS + s * 128 + cl), c1 = *(const f32x4*)(COS + s * 128 + cl + 4);
                    const f32x4 s0 = *(const f32x4*)(SIN + s * 128 + cl), s1 = *(const f32x4*)(SIN + s * 128 + cl + 4);
                    const f32x4 a0 = acc[ai][0][m][0] * sc, a1 = acc[ai][0][m][1] * sc, b0 = acc[ai][1][m][0] * sc, b1 = acc[ai][1][m][1] * sc;
                    const f32x4 o10 = a0 * c0 - b0 * s0, o11 = a1 * c1 - b1 * s1, o20 = a0 * s0 + b0 * c0, o21 = a1 * s1 + b1 * c1;
                    bf16_t* base = (pn < 4 ? Q : K) + (size_t)row * 1024 + (pn & 3) * 256 + cl;
                    *(u32x4*)(base) = pack8(o10, o11); *(u32x4*)(base + 128) = pack8(o20, o21);
                } else {
#pragma unroll
                    for (int bj = 0; bj < 2; ++bj) {
                        const int c = bj * HALF + cl;
                        f32x4 v0 = acc[ai][bj][m][0] * rs, v1 = acc[ai][bj][m][1] * rs;
                        if (pn < 16) { *(u32x4*)(V + (size_t)row * 2048 + (pn - 8) * 256 + c) = pack8(v0, v1); }
                        else {
#pragma unroll
                            for (int e = 0; e < 4; ++e) { v0[e] = silu_f(v0[e]); v1[e] = silu_f(v1[e]); }
                            *(u32x4*)(Z + (size_t)row * 2048 + (pn - 16) * 256 + c) = pack8(v0, v1); }
                    }
                }
            }
    }
};
struct EpiF32 {
    static constexpr bool PERM = true, AFTER_DRAIN = false;
    float* O; int ldc;
    __device__ __forceinline__ void operator()(const f32x4 (&acc)[2][2][4][2], const Unit& u, int wr, int wc, int fr, int fq) const {
        const int row0 = u.pm * BM + wr * 64 + fr, cl = u.pn * BM + wc * 32 + 8 * fq;
#pragma unroll
        for (int ai = 0; ai < 2; ++ai)
#pragma unroll
            for (int m = 0; m < 4; ++m)
#pragma unroll
                for (int bj = 0; bj < 2; ++bj) { float* p = O + (size_t)(row0 + ai * HALF + m * 16) * ldc + cl + bj * HALF;
                    *(f32x4*)p = acc[ai][bj][m][0]; *(f32x4*)(p + 4) = acc[ai][bj][m][1]; }
    }
};

template <class Epi, class Sched, bool ALIGN_EPI = false, bool SP2 = false>
__device__ __forceinline__ void gemm_phase(PG8_LAS unsigned char* lds, const Gemm g, const Sched& S, const Epi& E) {
    const int tid = threadIdx.x, wid = __builtin_amdgcn_readfirstlane(tid >> 6), lane = tid & 63, wr = wid >> 2, wc = wid & 3, fr = lane & 15, fq = lane >> 4;
    const int K = g.K, nt = K / BK;
    unsigned voffA[2], voffB[2];
#pragma unroll
    for (int i = 0; i < 2; ++i) { int R, C; stage_rc(tid * 16 + i * 8192, R, C); const int Rb = Epi::PERM ? ((R & ~31) + perm32(R & 31)) : R;
        voffA[i] = (unsigned)(R * K + C) * 2u; voffB[i] = (unsigned)(Rb * K + C) * 2u; }
    const size_t kstep = (size_t)(BK * 2);
    const size_t hstep = (size_t)HALF * K * 2;
    const size_t tstep = 2 * hstep;
    const unsigned ldsw = (unsigned)wid * 1024u;
    const int aoff = lds_byte(wr * 64 + fr, fq * 8), boff = lds_byte(wc * 32 + fr, fq * 8);
#define PG8_SA(b, h) (((b) * 2 + (h)) * HTB)
#define PG8_SB(b, h) ((4 + (b) * 2 + (h)) * HTB)
#define PG8_STAGE(bufoff, gbase, voff) do { _Pragma("unroll") for (int _i = 0; _i < 2; ++_i) \
        __builtin_amdgcn_global_load_lds((const unsigned*)((const char*)(gbase) + (voff)[_i]), (PG8_LAS unsigned*)(lds + (bufoff) + ldsw + _i * 8192), 16, 0, 0); } while (0)
#define PG8_LDA(dst, b, h) do { _Pragma("unroll") for (int m = 0; m < 4; ++m) _Pragma("unroll") for (int k = 0; k < 2; ++k) dst[m][k] = *(const PG8_LAS bf16x8*)(lds + PG8_SA(b, h) + aoff + m * 2048 + k * 1024); } while (0)
#define PG8_LDB(dst, b, h) do { _Pragma("unroll") for (int n = 0; n < 2; ++n) _Pragma("unroll") for (int k = 0; k < 2; ++k) dst[n][k] = *(const PG8_LAS bf16x8*)(lds + PG8_SB(b, h) + boff + n * 2048 + k * 1024); } while (0)
#define PG8_MMA(ai, bj, At, Bt) do { __builtin_amdgcn_s_setprio(1); _Pragma("unroll") for (int m = 0; m < 4; ++m) _Pragma("unroll") for (int n = 0; n < 2; ++n) _Pragma("unroll") for (int k = 0; k < 2; ++k) \
        acc[ai][bj][m][n] = __builtin_amdgcn_mfma_f32_16x16x32_bf16(Bt[n][k], At[m][k], acc[ai][bj][m][n], 0, 0, 0); __builtin_amdgcn_s_setprio(0); } while (0)
#define PG8_WAIT_V(n) asm volatile("s_waitcnt vmcnt(" #n ")" ::: "memory")
#define PG8_WAIT_L(n) asm volatile("s_waitcnt lgkmcnt(" #n ")" ::: "memory")
#define PG8_BAR __builtin_amdgcn_s_barrier()
#define PG8_SCHED __builtin_amdgcn_sched_barrier(0)
    Unit cur, nxt; int ui = 0;
    if (!S.next(0, cur)) return;
    f32x4 acc[2][2][4][2];
#pragma unroll
    for (int a = 0; a < 2; ++a)
#pragma unroll
        for (int b = 0; b < 2; ++b)
#pragma unroll
            for (int m = 0; m < 4; ++m)
#pragma unroll
                for (int n = 0; n < 2; ++n) acc[a][b][m][n] = (f32x4){0.f, 0.f, 0.f, 0.f};
    bf16x8 At[4][2], B0[2][2], B1[2][2];
    const char* cA = (const char*)g.A + (size_t)cur.pm * tstep; const char* cB = (const char*)g.Bt + (size_t)cur.pn * tstep;
    S.a_ready(cur);
    if constexpr (SP2) {
        PG8_STAGE(PG8_SB(0, 0), cB, voffB); PG8_STAGE(PG8_SB(0, 1), cB + hstep, voffB); PG8_STAGE(PG8_SA(0, 0), cA, voffA); PG8_STAGE(PG8_SA(0, 1), cA + hstep, voffA);
        if (wr == 1) PG8_BAR;
        PG8_WAIT_V(2); PG8_BAR;
        PG8_STAGE(PG8_SB(1, 0), cB + kstep, voffB); PG8_STAGE(PG8_SA(1, 0), cA + kstep, voffA); PG8_STAGE(PG8_SB(1, 1), cB + hstep + kstep, voffB);
        PG8_WAIT_V(6); PG8_BAR;
    } else {
        PG8_STAGE(PG8_SB(0, 0), cB, voffB); PG8_STAGE(PG8_SA(0, 0), cA, voffA); PG8_STAGE(PG8_SB(0, 1), cB + hstep, voffB); PG8_STAGE(PG8_SA(0, 1), cA + hstep, voffA);
        if (wr == 1) PG8_BAR;
        PG8_WAIT_V(4); PG8_BAR;
        PG8_STAGE(PG8_SB(1, 0), cB + kstep, voffB); PG8_STAGE(PG8_SA(1, 0), cA + kstep, voffA); PG8_STAGE(PG8_SB(1, 1), cB + hstep + kstep, voffB);
        PG8_WAIT_V(6); PG8_BAR;
    }
    for (;;) {
        const bool has_next = S.next(ui + 1, nxt);
        const char* nA = has_next ? (const char*)g.A + (size_t)nxt.pm * tstep : cA; const char* nB = has_next ? (const char*)g.Bt + (size_t)nxt.pn * tstep : cB;
        for (int t = 0; t < nt; t += 2) {
            const bool last = (t == nt - 2);
            const char* a1 = cA + (size_t)(t + 1) * kstep;
            const char* a2 = last ? nA : cA + (size_t)(t + 2) * kstep; const char* b2 = last ? nB : cB + (size_t)(t + 2) * kstep;
            const char* a3 = a2 + kstep; const char* b3 = b2 + kstep;
            if (last && has_next) S.a_ready(nxt);
            if constexpr (SP2) {
            PG8_LDB(B0, 0, 0); PG8_LDB(B1, 0, 1); PG8_SCHED; PG8_LDA(At, 0, 0); PG8_STAGE(PG8_SA(1, 1), a1 + hstep, voffA);
            PG8_WAIT_V(8); PG8_WAIT_L(0); PG8_BAR; PG8_MMA(0, 0, At, B0); PG8_MMA(0, 1, At, B1); PG8_BAR; PG8_SCHED;
            PG8_LDA(At, 0, 1); PG8_STAGE(PG8_SB(0, 0), b2, voffB); PG8_STAGE(PG8_SB(0, 1), b2 + hstep, voffB); PG8_STAGE(PG8_SA(0, 0), a2, voffA);
            PG8_WAIT_V(8); PG8_WAIT_L(0); PG8_BAR; PG8_MMA(1, 0, At, B0); PG8_MMA(1, 1, At, B1); PG8_BAR; PG8_SCHED;
            PG8_LDB(B0, 1, 0); PG8_LDB(B1, 1, 1); PG8_SCHED; PG8_LDA(At, 1, 0); PG8_STAGE(PG8_SA(0, 1), a2 + hstep, voffA);
            PG8_WAIT_V(8); PG8_WAIT_L(0); PG8_BAR; PG8_MMA(0, 0, At, B0); PG8_MMA(0, 1, At, B1); PG8_BAR; PG8_SCHED;
            PG8_LDA(At, 1, 1); PG8_STAGE(PG8_SB(1, 0), b3, voffB); PG8_STAGE(PG8_SB(1, 1), b3 + hstep, voffB); PG8_STAGE(PG8_SA(1, 0), a3, voffA);
            PG8_WAIT_V(8); PG8_WAIT_L(0); PG8_BAR; PG8_MMA(1, 0, At, B0); PG8_MMA(1, 1, At, B1); PG8_BAR; PG8_SCHED;
            } else {
            PG8_LDB(B0, 0, 0); PG8_SCHED; PG8_LDA(At, 0, 0); PG8_STAGE(PG8_SA(1, 1), a1 + hstep, voffA);
            PG8_WAIT_L(8); PG8_BAR; PG8_WAIT_L(0); PG8_MMA(0, 0, At, B0); PG8_BAR; PG8_SCHED;
            PG8_LDB(B1, 0, 1); PG8_STAGE(PG8_SB(0, 0), b2, voffB);
            PG8_BAR; PG8_WAIT_L(0); PG8_MMA(0, 1, At, B1); PG8_BAR;
            PG8_LDA(At, 0, 1); PG8_STAGE(PG8_SA(0, 0), a2, voffA);
            PG8_BAR; PG8_WAIT_L(0); PG8_MMA(1, 0, At, B0); PG8_BAR; PG8_SCHED;
            PG8_STAGE(PG8_SB(0, 1), b2 + hstep, voffB);
            PG8_WAIT_V(6); PG8_BAR; PG8_MMA(1, 1, At, B1); PG8_BAR;
            PG8_LDB(B0, 1, 0); PG8_SCHED; PG8_LDA(At, 1, 0); PG8_STAGE(PG8_SA(0, 1), a2 + hstep, voffA);
            PG8_WAIT_L(8); PG8_BAR; PG8_WAIT_L(0); PG8_MMA(0, 0, At, B0); PG8_BAR; PG8_SCHED;
            PG8_LDB(B1, 1, 1); PG8_STAGE(PG8_SB(1, 0), b3, voffB);
            PG8_BAR; PG8_WAIT_L(0); PG8_MMA(0, 1, At, B1); PG8_BAR;
            PG8_LDA(At, 1, 1); PG8_STAGE(PG8_SA(1, 0), a3, voffA);
            PG8_BAR; PG8_WAIT_L(0); PG8_MMA(1, 0, At, B0); PG8_BAR; PG8_SCHED;
            PG8_STAGE(PG8_SB(1, 1), b3 + hstep, voffB);
            PG8_WAIT_V(6); PG8_BAR; PG8_MMA(1, 1, At, B1); PG8_BAR;
            }
        }
        if constexpr (ALIGN_EPI) { if (wr == 0) PG8_BAR; }
        if constexpr (!Epi::AFTER_DRAIN) { E(acc, cur, wr, wc, fr, fq); S.done(cur); }
        if (!has_next) break;
#pragma unroll
        for (int a = 0; a < 2; ++a)
#pragma unroll
            for (int b = 0; b < 2; ++b)
#pragma unroll
                for (int m = 0; m < 4; ++m)
#pragma unroll
                    for (int n = 0; n < 2; ++n) acc[a][b][m][n] = (f32x4){0.f, 0.f, 0.f, 0.f};
        cur = nxt; cA = nA; cB = nB; ++ui;
        if constexpr (ALIGN_EPI) { if (wr == 1) PG8_BAR; }
    }
    PG8_WAIT_V(0);
    if constexpr (!ALIGN_EPI) { if (wr == 0) PG8_BAR; }
    PG8_BAR;
    if constexpr (Epi::AFTER_DRAIN) { E.fused(acc, cur, wr, wc, fr, fq, lds, wid, lane); S.done(cur); }
#undef PG8_SA
#undef PG8_SB
#undef PG8_STAGE
#undef PG8_LDA
#undef PG8_LDB
#undef PG8_MMA
#undef PG8_WAIT_V
#undef PG8_WAIT_L
#undef PG8_BAR
#undef PG8_SCHED
}
}
constexpr int NWAVES = 8, NTHR = 512;
constexpr int BATCH = 8, S = 2048, D = 1024, M = BATCH * S;
constexpr int NSA_NP = 5888, RET_NP = 6144;
constexpr int NCMP = 127;
constexpr float RMS_EPS = 1e-6f, GN_EPS = 1e-6f;
constexpr size_t MiB = 1u << 20;
constexpr size_t WS_CTL = 0, CTL_ZERO_BYTES = 1 * MiB;
constexpr size_t WS_COS = 1 * MiB, WS_SIN = 2 * MiB;
constexpr size_t WS_WIN = 4 * MiB;
constexpr size_t WS_WOUT = 16 * MiB;
constexpr size_t WS_HB = 24 * MiB;
constexpr size_t WS_ACT = 56 * MiB;
constexpr size_t NSA_Q = WS_ACT, NSA_KV = WS_ACT + 32 * MiB, NSA_Z = WS_ACT + 80 * MiB, NSA_GT = WS_ACT + 176 * MiB, NSA_KC = WS_ACT + 179 * MiB, NSA_VC = WS_ACT + 180 * MiB;
constexpr size_t NSA_YO = NSA_Z;
constexpr size_t RET_Q = WS_ACT, RET_K = WS_ACT + 32 * MiB, RET_V = WS_ACT + 64 * MiB, RET_Z = WS_ACT + 128 * MiB;
constexpr size_t RET_YO = RET_Q;
constexpr size_t WS_END = WS_ACT + 192 * MiB;
static_assert(WS_END <= 256 * MiB, "d_ws map");
constexpr int CW_TMO = 0, CW_CODE = 1;
constexpr int CW_BAR = 4096;
constexpr int CW_RSS = 16384;
static_assert((CW_RSS + 5 * 16384) * 4 <= (int)CTL_ZERO_BYTES, "CTL words inside the memset region");
constexpr int RING_OFF = 0, RING_BYTES = 131072;
constexpr int LDSCTL_OFF = RING_BYTES, MISC_OFF = LDSCTL_OFF + 320;
constexpr int LDS_BYTES = 147456;
#define GAS __attribute__((address_space(1)))
#define LAS __attribute__((address_space(3)))
typedef unsigned short bf16;
typedef unsigned v4u __attribute__((ext_vector_type(4)));
typedef float f32x4 __attribute__((ext_vector_type(4)));
typedef GAS unsigned gu32;
#define RLX_AGENT __ATOMIC_RELAXED, __HIP_MEMORY_SCOPE_AGENT
#define LDS_WAIT() asm volatile("s_waitcnt lgkmcnt(0)" ::: "memory")
#define VM_WAIT() asm volatile("s_waitcnt vmcnt(0)" ::: "memory")
__device__ __forceinline__ unsigned f2bf(float f) { unsigned u = __builtin_bit_cast(unsigned, f); return (u + 0x7fffu + ((u >> 16) & 1u)) >> 16; }
__device__ __forceinline__ unsigned pk2(float lo, float hi) { return f2bf(lo) | (f2bf(hi) << 16); }
__device__ __forceinline__ float bf2f(unsigned short b) { return __builtin_bit_cast(float, (unsigned)b << 16); }
__device__ __forceinline__ float bflo(unsigned w) { return __builtin_bit_cast(float, w << 16); }
__device__ __forceinline__ float bfhi(unsigned w) { return __builtin_bit_cast(float, w & 0xffff0000u); }
__device__ __forceinline__ float wave_sum(float v) {
#pragma unroll
    for (int o = 1; o < 64; o <<= 1) v += __shfl_xor(v, o);
    return v;
}
__device__ __forceinline__ float wave_max(float v) {
#pragma unroll
    for (int o = 1; o < 64; o <<= 1) v = fmaxf(v, __shfl_xor(v, o));
    return v;
}
#define XB_TMO      128
#define XB_XCNT(j)  (256  + 64 * (j))
#define XB_XSUB(j)  (1280 + 64 * (j))
#define XB_XGEN(j)  (2304 + 64 * (j))
#define XB_TOP      3328
#define XB_TOPGEN   3392
#define XCD_BAR_WORDS 3456
#define XB_SPIN_CAP (1u << 18)

__device__ __forceinline__ unsigned xb_ld(unsigned* p)              { return __hip_atomic_load(p, __ATOMIC_RELAXED, __HIP_MEMORY_SCOPE_AGENT); }
__device__ __forceinline__ unsigned xb_add(unsigned* p, unsigned v) { return __hip_atomic_fetch_add(p, v, __ATOMIC_RELAXED, __HIP_MEMORY_SCOPE_AGENT); }
__device__ __forceinline__ unsigned xb_xcc_id() { return (unsigned)__builtin_amdgcn_s_getreg((3 << 11) | 20) & 0xFu; }
#define XB_SPIN(cond, bar) do { unsigned _sp = 0; while (cond) { __builtin_amdgcn_s_sleep(1); \
    if ((++_sp & 255u) == 0u) { if (xb_ld(&(bar)[XB_TMO])) break; if (_sp > XB_SPIN_CAP) { atomicAdd(&(bar)[XB_TMO], 1u); break; } } } } while (0)

struct XcdBarrier {
    unsigned* bar; unsigned x;
    volatile LAS unsigned* st;
};

__device__ __forceinline__ XcdBarrier xcd_barrier_post(unsigned* bar, volatile LAS unsigned* st) {
    XcdBarrier b; b.bar = bar; b.x = xb_xcc_id(); b.st = st;
    if (threadIdx.x == 0) (void)xb_add(&bar[XB_XCNT(b.x)], 1u);
    return b;
}
__device__ __forceinline__ void xcd_barrier_complete(unsigned* bar, unsigned x, unsigned& nloc, unsigned& nx) {
    const unsigned G = gridDim.x * gridDim.y * gridDim.z;
    unsigned sum, cnt, mine, sp = 0u;
    for (;;) {
        sum = 0u; cnt = 0u; mine = 0u;
#pragma unroll
        for (unsigned j = 0; j < 16; ++j) { const unsigned c = xb_ld(&bar[XB_XCNT(j)]); sum += c; cnt += (c > 0u) ? 1u : 0u; mine = (j == x) ? c : mine; }
        if (sum == G) break;
        __builtin_amdgcn_s_sleep(1);
        if ((++sp & 255u) == 0u) { if (xb_ld(&bar[XB_TMO])) break; if (sp > XB_SPIN_CAP) { atomicAdd(&bar[XB_TMO], 1u); break; } }
    }
    nloc = mine > 0u ? mine : 1u; nx = cnt > 0u ? cnt : 1u;
}

__device__ __forceinline__ void xcd_barrier(const XcdBarrier& b) {
    asm volatile("s_waitcnt vmcnt(0)" ::: "memory");
    __syncthreads();
    if (threadIdx.x == 0) {
        unsigned* bar = b.bar;
        __builtin_amdgcn_s_waitcnt(0);
        unsigned nloc = b.st[0], nx = b.st[1];
        if (nloc == 0u) { xcd_barrier_complete(bar, b.x, nloc, nx); b.st[0] = nloc; b.st[1] = nx; }
        const unsigned old = xb_add(&bar[XB_XSUB(b.x)], 1u);
        const unsigned gen = old / nloc;
        if (old + 1u == (gen + 1u) * nloc) {
            __builtin_amdgcn_fence(__ATOMIC_RELEASE, "agent");
            asm volatile("s_waitcnt vmcnt(0)" ::: "memory");
            const unsigned og = xb_add(&bar[XB_TOP], 1u);
            const unsigned tg = og / nx;
            if (og + 1u == (tg + 1u) * nx) xb_add(&bar[XB_TOPGEN], 1u);
            else XB_SPIN(xb_ld(&bar[XB_TOPGEN]) == tg, bar);
            __builtin_amdgcn_fence(__ATOMIC_ACQUIRE, "agent");
            xb_add(&bar[XB_XGEN(b.x)], 1u);
            asm volatile("s_waitcnt vmcnt(0)" ::: "memory");
        } else {
            XB_SPIN(xb_ld(&bar[XB_XGEN(b.x)]) == gen, bar);
            __builtin_amdgcn_fence(__ATOMIC_ACQUIRE, "agent");
            asm volatile("s_waitcnt vmcnt(0)" ::: "memory");
        }
    }
    __syncthreads();
}

struct Ctx { LAS unsigned char* lds; int tid, lane, wave, vcu, G; const float* in[15]; float* out; unsigned char* ws; };
enum { IN_X = 0, IN_PRE, IN_POST, IN_TAB, IN_NWIN, IN_NWOUT, IN_KPOS, IN_KW1, IN_KW2, IN_VPOS, IN_VW1, IN_VW2, IN_RWIN, IN_RWOUT, IN_GN };

__device__ __forceinline__ int t5_bucket(int d) { int r = 16 + (int)((16.0f / 3.0f) * (__log2f((float)(d < 1 ? 1 : d)) - 4.0f)); r = r > 31 ? 31 : r; return d < 16 ? d : r; }

__device__ __forceinline__ int nsa_src_col(int n) { return n < 2560 ? n : (n < 5632 ? n + 48 : (n < 5680 ? n - 3072 : -1)); }
template <int MODE> __device__ __forceinline__ void convert_item(const float* W, int K, int Nsrc, const float* gain, bf16* WT, LAS float* scr, int item, int nblk, int lane) {
    const int kb = item / nblk, nb = item % nblk, k0 = 64 * kb, n0 = 32 * nb;
    const int n = n0 + (lane & 31), sc = MODE == 1 ? nsa_src_col(n) : n;
#pragma unroll 8
    for (int i = 0; i < 32; ++i) { const int kk = 2 * i + (lane >> 5); float v = 0.f;
        if (sc >= 0) { v = W[(size_t)(k0 + kk) * Nsrc + sc]; if (gain) v *= gain[k0 + kk]; }
        scr[kk * 33 + (lane & 31)] = v; }
    LDS_WAIT();
    const int c = lane & 7;
#pragma unroll
    for (int j = 0; j < 4; ++j) { const int nn = (lane >> 3) + 8 * j; const LAS float* s = scr + (8 * c) * 33 + nn;
        v4u o; o.x = pk2(s[0 * 33], s[1 * 33]); o.y = pk2(s[2 * 33], s[3 * 33]); o.z = pk2(s[4 * 33], s[5 * 33]); o.w = pk2(s[6 * 33], s[7 * 33]);
        *(v4u*)(WT + (size_t)(n0 + nn) * K + k0 + 8 * c) = o; }
    LDS_WAIT();
}
template <int MODE> __device__ __forceinline__ void convert_weights(const Ctx& C, const float* W, int K, int Nsrc, int Ndst, const float* gain, bf16* WT) {
    LAS float* scr = (LAS float*)(C.lds + C.wave * 16384);
    const int gw = C.vcu * NWAVES + C.wave, NGW = C.G * NWAVES, nblk = Ndst / 32, nitems = (K / 64) * nblk;
    for (int it = gw; it < nitems; it += NGW) convert_item<MODE>(W, K, Nsrc, gain, WT, scr, it, nblk, C.lane);
}

__device__ __forceinline__ void p0_rows(const Ctx& C) {
    const int gw = C.vcu * NWAVES + C.wave, NGW = C.G * NWAVES;
    bf16* HB = (bf16*)(C.ws + WS_HB); float* rss = (float*)(C.ws + WS_CTL) + CW_RSS;
    for (int m = gw; m < M; m += NGW) {
        const f32x4* xr = (const f32x4*)(C.in[IN_X] + (size_t)m * D) + C.lane; f32x4 v[4]; float s = 0.f;
#pragma unroll
        for (int j = 0; j < 4; ++j) { v[j] = xr[64 * j]; s += (v[j].x * v[j].x + v[j].y * v[j].y) + (v[j].z * v[j].z + v[j].w * v[j].w); }
        s = wave_sum(s);
        unsigned long long* o8 = (unsigned long long*)(HB + (size_t)m * D) + C.lane;
#pragma unroll
        for (int j = 0; j < 4; ++j) o8[64 * j] = (unsigned long long)pk2(v[j].x, v[j].y) | ((unsigned long long)pk2(v[j].z, v[j].w) << 32);
        if (C.lane == 0) rss[m] = s;
    }
}
__device__ __forceinline__ void p0_tables(const Ctx& C) {
    float* COS = (float*)(C.ws + WS_COS); float* SIN = (float*)(C.ws + WS_SIN);
    for (int idx = C.vcu * NTHR + C.tid; idx < S * 128; idx += C.G * NTHR) {
        const int s = idx >> 7, i = idx & 127;
        const float inv = (float)(1.0 / exp2((double)i * (13.287712379549449 / 127.0)));
        const float ang = (float)s * inv;
        double rev = (double)ang * 0.15915494309189535; rev -= floor(rev + 0.5);
        const float rf = (float)rev;
        COS[idx] = __builtin_amdgcn_cosf(rf); SIN[idx] = __builtin_amdgcn_sinf(rf);
    }
}

__device__ __forceinline__ void naive_compress(const Ctx& C, int slot) {
    LAS float* xs = (LAS float*)(C.lds);
    LAS float* hid = (LAS float*)(C.lds + 32768);
    const bf16* KV = (const bf16*)(C.ws + NSA_KV);
    for (int unit = C.vcu; unit < 2 * BATCH * NCMP; unit += C.G) {
        const int kv = unit / (BATCH * NCMP), rem = unit % (BATCH * NCMP), b = rem / NCMP, c = rem % NCMP;
        const float* pos = C.in[kv ? IN_VPOS : IN_KPOS] + (size_t)slot * 2048;
        const float* w1 = C.in[kv ? IN_VW1 : IN_KW1] + (size_t)slot * 2048 * 256;
        const float* w2 = C.in[kv ? IN_VW2 : IN_KW2] + (size_t)slot * 256 * 64;
        const bf16* src = KV + (size_t)kv * (16384 * 256);
        bf16* dst = (bf16*)(C.ws + (kv ? NSA_VC : NSA_KC));
        for (int idx = C.tid; idx < 8192; idx += NTHR) { const int g = idx >> 11, k = idx & 2047;
            xs[idx] = bf2f(src[((size_t)((b * 4 + g) * 2048 + 16 * c)) * 64 + k]) + pos[k]; }
        __syncthreads();
        { const int j = C.tid & 255, hf = C.tid >> 8; float a0 = 0.f, a1 = 0.f;
          const LAS float* x0 = xs + (2 * hf) * 2048; const LAS float* x1 = x0 + 2048;
#pragma unroll 4
          for (int k = 0; k < 2048; ++k) { const float w = w1[(size_t)k * 256 + j]; a0 += x0[k] * w; a1 += x1[k] * w; }
          hid[(2 * hf) * 256 + j] = a0 / (1.0f + __expf(-a0)); hid[(2 * hf + 1) * 256 + j] = a1 / (1.0f + __expf(-a1)); }
        __syncthreads();
        if (C.tid < 256) { const int g = C.tid >> 6, d = C.tid & 63; float a = 0.f;
#pragma unroll 4
            for (int j = 0; j < 256; ++j) a += hid[g * 256 + j] * w2[j * 64 + d];
            dst[((size_t)((b * 4 + g) * 128 + c)) * 64 + d] = (bf16)f2bf(a); }
        __syncthreads();
    }
}

__device__ __forceinline__ float dot64(const LAS float* q, const bf16* krow) {
    const v4u* kp = (const v4u*)krow; float s = 0.f;
#pragma unroll
    for (int c = 0; c < 8; ++c) { const v4u w = kp[c]; const LAS float* qq = q + c * 8;
        s += qq[0] * bflo(w.x) + qq[1] * bfhi(w.x) + qq[2] * bflo(w.y) + qq[3] * bfhi(w.y) + qq[4] * bflo(w.z) + qq[5] * bfhi(w.z) + qq[6] * bflo(w.w) + qq[7] * bfhi(w.w); }
    return s;
}
struct SoftAcc { float m, l, o; };
__device__ __forceinline__ void attn_block(SoftAcc& a, const LAS float* q, LAS float* pw, const bf16* Kblk, const bf16* Vblk, float bias, bool valid, int lane) {
    const float lg = valid ? dot64(q, Kblk + lane * 64) * 0.125f + bias : -1e30f;
    const float bm = wave_max(lg);
    if (bm <= -1e29f) return;
    const float mn = fmaxf(a.m, bm), sc = __expf(a.m - mn), p = valid ? __expf(lg - mn) : 0.f;
    a.l = a.l * sc + wave_sum(p); a.o *= sc; a.m = mn;
    pw[lane] = p; LDS_WAIT();
    float o = a.o;
#pragma unroll 8
    for (int k = 0; k < 64; ++k) o += pw[k] * bf2f(Vblk[k * 64 + lane]);
    a.o = o; LDS_WAIT();
}
__device__ __forceinline__ void naive_nsa_attn(const Ctx& C) {
    LAS float* lut = (LAS float*)(C.lds);
    LAS float* qs = (LAS float*)(C.lds + 8448);
    LAS float* pc = (LAS float*)(C.lds + 10496);
    LAS float* pwA = (LAS float*)(C.lds + 14592);
    const float* tab = C.in[IN_TAB];
    for (int i = C.tid; i < 16 * 129; i += NTHR) { const int h = i / 129, d = i % 129; lut[i] = tab[t5_bucket(d) * 16 + h]; }
    __syncthreads();
    bf16* Q = (bf16*)(C.ws + NSA_Q); const bf16* KV = (const bf16*)(C.ws + NSA_KV); const bf16* Z = (const bf16*)(C.ws + NSA_Z); const float* GT = (const float*)(C.ws + NSA_GT);
    const bf16* KC = (const bf16*)(C.ws + NSA_KC); const bf16* VC = (const bf16*)(C.ws + NSA_VC);
    const int w = C.wave, lane = C.lane;
    LAS float* q = qs + w * 64; LAS float* pw = pwA + w * 64; LAS float* pcw = pc + w * 128;
    for (int unit = C.vcu; unit < BATCH * S * 2; unit += C.G) {
        const int b = unit >> 12, rem = unit & 4095, t = rem >> 1, gp = rem & 1, g = gp * 2 + (w >> 2), h = g * 4 + (w & 3);
        const int row = b * S + t;
        const LAS float* lh = lut + h * 129;
        q[lane] = bf2f(Q[(size_t)row * 1024 + h * 64 + lane]); LDS_WAIT();
        const size_t gofs = (size_t)(b * 4 + g);
        float o_cmp;
        { const bf16* KCb = KC + gofs * 128 * 64; const bf16* VCb = VC + gofs * 128 * 64;
          const int e0 = 16 * lane + 31, e1 = 16 * (64 + lane) + 31; const bool v0 = e0 <= t, v1 = (lane < 63) && (e1 <= t);
          const int d0 = t - e0, d1 = t - e1;
          const float lg0 = v0 ? dot64(q, KCb + lane * 64) * 0.125f + lh[d0 > 128 ? 128 : (d0 < 0 ? 0 : d0)] : -1e30f;
          const float lg1 = v1 ? dot64(q, KCb + (64 + lane) * 64) * 0.125f + lh[d1 > 128 ? 128 : (d1 < 0 ? 0 : d1)] : -1e30f;
          const float mx = wave_max(fmaxf(lg0, lg1));
          float p0 = v0 ? __expf(lg0 - mx) : 0.f, p1 = v1 ? __expf(lg1 - mx) : 0.f;
          const float l = wave_sum(p0 + p1), inv = l > 0.f ? 1.0f / l : 0.f;
          p0 *= inv; p1 *= inv; pcw[lane] = p0; pcw[64 + lane] = p1; LDS_WAIT();
          float o = 0.f;
#pragma unroll 8
          for (int c = 0; c < NCMP; ++c) o += pcw[c] * bf2f(VCb[c * 64 + lane]);
          o_cmp = o; }
        __syncthreads();
        unsigned selmask;
        { const int j = lane & 31, cur = t >> 6; float imp = 0.f; const LAS float* pg = pc + (w & 4) * 128;
          const int clo = 4 * j - 1 < 0 ? 0 : 4 * j - 1, chi = 4 * j + 3 > 126 ? 126 : 4 * j + 3;
          for (int r = 0; r < 4; ++r) for (int c = clo; c <= chi; ++c) imp += pg[r * 128 + c];
          const bool valid = j <= cur, forced = (j == 0) || (j == cur) || (j == cur - 1);
          const float score = valid ? imp + (forced ? 1000.0f : 0.f) : -1e30f;
          int rank = 0;
          for (int i = 0; i < 32; ++i) { const float si = __shfl(score, i); rank += ((si > score) || (si == score && i < j)) ? 1 : 0; }
          selmask = (unsigned)(__ballot(rank < 16) & 0xffffffffull); }
        __syncthreads();
        const int cur = t >> 6;
        SoftAcc as{-1e30f, 0.f, 0.f};
        { const bf16* Kb = KV + (size_t)2 * (16384 * 256) + gofs * 2048 * 64; const bf16* Vb = KV + (size_t)3 * (16384 * 256) + gofs * 2048 * 64;
          for (int j = 0; j <= cur; ++j) if ((selmask >> j) & 1u) { const int pos = 64 * j + lane, dist = t - pos;
              attn_block(as, q, pw, Kb + (size_t)j * 4096, Vb + (size_t)j * 4096, lh[dist > 128 ? 128 : (dist < 0 ? 0 : dist)], dist >= 0, lane); } }
        SoftAcc aw{-1e30f, 0.f, 0.f};
        { const bf16* Kb = KV + (size_t)4 * (16384 * 256) + gofs * 2048 * 64; const bf16* Vb = KV + (size_t)5 * (16384 * 256) + gofs * 2048 * 64;
          const int jlo = (t - 511 < 0 ? 0 : t - 511) >> 6;
          for (int j = jlo; j <= cur; ++j) { const int pos = 64 * j + lane, dist = t - pos;
              attn_block(aw, q, pw, Kb + (size_t)j * 4096, Vb + (size_t)j * 4096, lh[dist > 128 ? 128 : (dist < 0 ? 0 : dist)], dist >= 0 && dist < 512, lane); } }
        const float o_slc = as.l > 0.f ? as.o / as.l : 0.f, o_win = aw.l > 0.f ? aw.o / aw.l : 0.f;
        const float* gt = GT + (size_t)row * 48; const bf16* zr = Z + (size_t)row * 3072 + h * 64 + lane;
        const float y = gt[h] * o_cmp * bf2f(zr[0]) + gt[16 + h] * o_slc * bf2f(zr[1024]) + gt[32 + h] * o_win * bf2f(zr[2048]);
        Q[(size_t)row * 1024 + h * 64 + lane] = (bf16)f2bf(y);
    }
}

__device__ __forceinline__ void naive_retention(const Ctx& C, int slot) {
    LAS float* qs = (LAS float*)(C.lds);
    LAS float* as = (LAS float*)(C.lds + 8192);
    LAS float* red = (LAS float*)(C.lds + 8192 + 65536);
    const bf16* Qr = (const bf16*)(C.ws + RET_Q); const bf16* Kr = (const bf16*)(C.ws + RET_K); const bf16* Vr = (const bf16*)(C.ws + RET_V); bf16* Zr = (bf16*)(C.ws + RET_Z);
    const float* gn = C.in[IN_GN] + (size_t)slot * 2048;
    const int tid = C.tid, lane = C.lane, w = C.wave;
    for (int unit = C.vcu; unit < BATCH * 4 * 256; unit += C.G) {
        const int b = unit >> 10, h = (unit >> 8) & 3, t0 = (unit & 255) * 8, tmax = t0 + 7;
        for (int idx = tid; idx < 2048; idx += NTHR) { const int i = idx >> 8, d = idx & 255; qs[idx] = bf2f(Qr[(size_t)(b * S + t0 + i) * 1024 + h * 256 + d]); }
        __syncthreads();
        const float lg = __log2f(1.0f - exp2f(-5.0f - (float)h));
        for (int s = tid; s <= tmax; s += NTHR) {
            const v4u* kp = (const v4u*)(Kr + (size_t)(b * S + s) * 1024 + h * 256);
            float acc[8];
#pragma unroll
            for (int i = 0; i < 8; ++i) acc[i] = 0.f;
#pragma unroll 2
            for (int c = 0; c < 32; ++c) { const v4u kw = kp[c];
                const float k0 = bflo(kw.x), k1 = bfhi(kw.x), k2 = bflo(kw.y), k3 = bfhi(kw.y), k4 = bflo(kw.z), k5 = bfhi(kw.z), k6 = bflo(kw.w), k7 = bfhi(kw.w);
#pragma unroll
                for (int i = 0; i < 8; ++i) { const LAS float* qq = qs + i * 256 + c * 8;
                    acc[i] += qq[0] * k0 + qq[1] * k1 + qq[2] * k2 + qq[3] * k3 + qq[4] * k4 + qq[5] * k5 + qq[6] * k6 + qq[7] * k7; } }
#pragma unroll
            for (int i = 0; i < 8; ++i) { const int dist = t0 + i - s; as[i * 2048 + s] = dist >= 0 ? acc[i] * exp2f((float)dist * lg) : 0.f; }
        }
        __syncthreads();
        float o[8];
#pragma unroll
        for (int i = 0; i < 8; ++i) o[i] = 0.f;
        { const bf16* vp = Vr + (size_t)(b * S) * 2048 + h * 512 + tid;
#pragma unroll 4
          for (int s = 0; s <= tmax; ++s) { const float vv = bf2f(vp[(size_t)s * 2048]);
#pragma unroll
              for (int i = 0; i < 8; ++i) o[i] += as[i * 2048 + s] * vv; } }
        float mu[8];
#pragma unroll
        for (int i = 0; i < 8; ++i) { const float sm = wave_sum(o[i]); if (lane == 0) red[w * 8 + i] = sm; }
        __syncthreads();
#pragma unroll
        for (int i = 0; i < 8; ++i) { float sm = 0.f;
#pragma unroll
            for (int ww = 0; ww < 8; ++ww) sm += red[ww * 8 + i];
            mu[i] = sm * (1.0f / 512.0f); }
        __syncthreads();
#pragma unroll
        for (int i = 0; i < 8; ++i) { const float d = o[i] - mu[i]; const float sq = wave_sum(d * d); if (lane == 0) red[w * 8 + i] = sq; }
        __syncthreads();
#pragma unroll
        for (int i = 0; i < 8; ++i) { float sq = 0.f;
#pragma unroll
            for (int ww = 0; ww < 8; ++ww) sq += red[ww * 8 + i];
            const float rstd = rsqrtf(sq * (1.0f / 512.0f) + GN_EPS);
            const size_t idx = (size_t)(b * S + t0 + i) * 2048 + h * 512 + tid;
            Zr[idx] = (bf16)f2bf((o[i] - mu[i]) * rstd * gn[h * 512 + tid] * bf2f(Zr[idx])); }
        __syncthreads();
    }
}

__device__ __forceinline__ void naive_norm_res(const Ctx& C, int layer, const float* YO) {
    const int gw = C.vcu * NWAVES + C.wave, NGW = C.G * NWAVES;
    bf16* HB = (bf16*)(C.ws + WS_HB); float* rss = (float*)(C.ws + WS_CTL) + CW_RSS + (size_t)(layer + 1) * 16384;
    const float* hp = layer == 0 ? C.in[IN_X] : C.out; const float* gain = C.in[IN_POST] + (size_t)layer * D;
    for (int m = gw; m < M; m += NGW) {
        const f32x4* yr = (const f32x4*)(YO + (size_t)m * D) + C.lane; f32x4 v[4]; float s = 0.f;
#pragma unroll
        for (int j = 0; j < 4; ++j) { v[j] = yr[64 * j]; s += (v[j].x * v[j].x + v[j].y * v[j].y) + (v[j].z * v[j].z + v[j].w * v[j].w); }
        const float rstd = rsqrtf(wave_sum(s) * (1.0f / 1024.0f) + RMS_EPS);
        const f32x4* hr = (const f32x4*)(hp + (size_t)m * D) + C.lane; const f32x4* gr = (const f32x4*)gain + C.lane;
        f32x4* orow = (f32x4*)(C.out + (size_t)m * D) + C.lane;
        unsigned long long* o8 = (unsigned long long*)(HB + (size_t)m * D) + C.lane; float s2 = 0.f;
#pragma unroll
        for (int j = 0; j < 4; ++j) { const f32x4 hn = hr[64 * j] + v[j] * rstd * gr[64 * j]; orow[64 * j] = hn;
            s2 += (hn.x * hn.x + hn.y * hn.y) + (hn.z * hn.z + hn.w * hn.w);
            o8[64 * j] = (unsigned long long)pk2(hn.x, hn.y) | ((unsigned long long)pk2(hn.z, hn.w) << 32); }
        s2 = wave_sum(s2);
        if (C.lane == 0) rss[m] = s2;
    }
}
constexpr int PH_PER_PAIR = 9, N_PHASES = 1 + 2 * PH_PER_PAIR;
struct Args { const float* in[15]; float* out; unsigned char* ws; int ph_lo, ph_hi; };
#define IN(k) (lo <= (k) && (k) < hi)
#define SEAM(k) do { if (IN(k) && IN((k) + 1)) xcd_barrier(bar); } while (0)
template <int p> __device__ __forceinline__ void layer_pair(const Ctx& C, const XcdBarrier& bar, const int lo, const int hi) {
    unsigned char* ws = C.ws;
    float* rss_base = (float*)(ws + WS_CTL) + CW_RSS;
    bf16* WIN = (bf16*)(ws + WS_WIN); bf16* WOUT = (bf16*)(ws + WS_WOUT); bf16* HB = (bf16*)(ws + WS_HB);
        const int pb = 1 + PH_PER_PAIR * p, L0 = 2 * p, L1 = 2 * p + 1;
        if (IN(pb + 0)) {
            pg8::Gemm g{HB, WIN, M, NSA_NP, 1024}; pg8::StaticOrder So; So.init(M, NSA_NP, C.G, (int)blockIdx.x);
            pg8::EpiNsaProj E{rss_base + (size_t)L0 * 16384, (bf16*)(ws + NSA_Q), (bf16*)(ws + NSA_KV), (bf16*)(ws + NSA_Z), (float*)(ws + NSA_GT)};
            pg8::gemm_phase<pg8::EpiNsaProj, pg8::StaticOrder, true, true>(C.lds + RING_OFF, g, So, E);
        }
        SEAM(pb + 0);
        if (IN(pb + 1)) {
            convert_weights<0>(C, C.in[IN_NWOUT] + (size_t)p * 1024 * 1024, 1024, 1024, 1024, nullptr, WOUT);
            convert_weights<0>(C, C.in[IN_RWIN] + (size_t)p * 1024 * 6144, 1024, 6144, RET_NP, C.in[IN_PRE] + (size_t)L1 * D, WIN);
            __syncthreads();
            naive_compress(C, p);
        }
        SEAM(pb + 1);
        if (IN(pb + 2)) naive_nsa_attn(C);
        SEAM(pb + 2);
        if (IN(pb + 3)) {
            pg8::Gemm g{(const bf16*)(ws + NSA_Q), WOUT, M, 1024, 1024}; pg8::StaticOrder So; So.init(M, 1024, C.G, (int)blockIdx.x);
            pg8::EpiF32 E{(float*)(ws + NSA_YO), 1024};
            pg8::gemm_phase<pg8::EpiF32, pg8::StaticOrder, true, true>(C.lds + RING_OFF, g, So, E);
        }
        SEAM(pb + 3);
        if (IN(pb + 4)) naive_norm_res(C, L0, (const float*)(ws + NSA_YO));
        SEAM(pb + 4);
        if (IN(pb + 5)) {
            pg8::Gemm g{HB, WIN, M, RET_NP, 1024}; pg8::StaticOrder So; So.init(M, RET_NP, C.G, (int)blockIdx.x);
            pg8::EpiRetProj E{rss_base + (size_t)L1 * 16384, (const float*)(ws + WS_COS), (const float*)(ws + WS_SIN), (bf16*)(ws + RET_Q), (bf16*)(ws + RET_K), (bf16*)(ws + RET_V), (bf16*)(ws + RET_Z)};
            pg8::gemm_phase<pg8::EpiRetProj, pg8::StaticOrder, true, true>(C.lds + RING_OFF, g, So, E);
        }
        SEAM(pb + 5);
        if (IN(pb + 6)) {
            convert_weights<0>(C, C.in[IN_RWOUT] + (size_t)p * 2048 * 1024, 2048, 1024, 1024, nullptr, WOUT);
            if (p == 0) convert_weights<1>(C, C.in[IN_NWIN] + (size_t)1 * 1024 * 5680, 1024, 5680, NSA_NP, C.in[IN_PRE] + (size_t)2 * D, WIN);
            __syncthreads();
            naive_retention(C, p);
        }
        SEAM(pb + 6);
        if (IN(pb + 7)) {
            pg8::Gemm g{(const bf16*)(ws + RET_Z), WOUT, M, 1024, 2048}; pg8::StaticOrder So; So.init(M, 1024, C.G, (int)blockIdx.x);
            pg8::EpiF32 E{(float*)(ws + RET_YO), 1024};
            pg8::gemm_phase<pg8::EpiF32, pg8::StaticOrder, true, true>(C.lds + RING_OFF, g, So, E);
        }
        SEAM(pb + 7);
        if (IN(pb + 8)) naive_norm_res(C, L1, (const float*)(ws + RET_YO));
        SEAM(pb + 8);
    }
__global__ void __launch_bounds__(NTHR, 2) hybrid_fwd(Args args) {
    extern __shared__ __attribute__((aligned(16))) unsigned char lds[];
    Ctx C;
    C.lds = (LAS unsigned char*)lds;
    C.tid = threadIdx.x; C.lane = C.tid & 63; C.wave = __builtin_amdgcn_readfirstlane(C.tid >> 6);
    C.G = gridDim.x; { const int bx = blockIdx.x; C.vcu = (C.G % 8 == 0) ? (bx % 8) * (C.G / 8) + bx / 8 : bx; }
#pragma unroll
    for (int i = 0; i < 15; ++i) C.in[i] = args.in[i];
    C.out = args.out; C.ws = args.ws;
    unsigned char* ws = args.ws;
    gu32* ctl = (gu32*)(ws + WS_CTL);
    volatile LAS unsigned* MISC = (volatile LAS unsigned*)(C.lds + MISC_OFF);
    for (int u = C.tid; u < (LDS_BYTES - LDSCTL_OFF) / 4; u += NTHR) ((LAS unsigned*)(C.lds + LDSCTL_OFF))[u] = 0u;
    __syncthreads();
    XcdBarrier bar = xcd_barrier_post((unsigned*)(ctl + CW_BAR), MISC + 8);
    const int lo = args.ph_lo, hi = args.ph_hi;
    float* rss_base = (float*)(ws + WS_CTL) + CW_RSS;
    bf16* WIN = (bf16*)(ws + WS_WIN); bf16* WOUT = (bf16*)(ws + WS_WOUT); bf16* HB = (bf16*)(ws + WS_HB);

    if (IN(0)) {
        convert_weights<1>(C, C.in[IN_NWIN], 1024, 5680, NSA_NP, C.in[IN_PRE], WIN);
        p0_rows(C); p0_tables(C);
    }
    SEAM(0);
    layer_pair<0>(C, bar, lo, hi);
    layer_pair<1>(C, bar, lo, hi);
#undef IN
#undef SEAM
}

#ifndef N_LAUNCH_MODE
#define N_LAUNCH_MODE 1
#endif
extern "C" void kernel_launch(void* const* d_in, const int* in_sizes, int n_in, void* d_out, int out_size, void* d_ws, size_t ws_size, hipStream_t stream) {
    static int grid = 0;
    if (grid == 0) {
        if (n_in != 15 || out_size != M * D || ws_size < WS_END) { fprintf(stderr, "kernel_launch: unexpected problem shape (n_in %d, out %d, ws %zu)\n", n_in, out_size, ws_size); grid = -1; return; }
        int dev = 0, cus = 0, per_cu = 0;
        if (hipGetDevice(&dev) != hipSuccess || hipDeviceGetAttribute(&cus, hipDeviceAttributeMultiprocessorCount, dev) != hipSuccess) { grid = -1; return; }
        if (hipFuncSetAttribute((const void*)hybrid_fwd, hipFuncAttributeMaxDynamicSharedMemorySize, LDS_BYTES) != hipSuccess) { fprintf(stderr, "kernel_launch: hipFuncSetAttribute failed\n"); grid = -1; return; }
        if (hipOccupancyMaxActiveBlocksPerMultiprocessor(&per_cu, (const void*)hybrid_fwd, NTHR, LDS_BYTES) != hipSuccess || per_cu < 1) { fprintf(stderr, "kernel_launch: occupancy query reports %d blocks per CU\n", per_cu); }
        (void)hipGetLastError();
        grid = cus;
    }
    if (grid < 0) return;
    if (hipMemsetAsync((char*)d_ws + WS_CTL, 0, CTL_ZERO_BYTES, stream) != hipSuccess) return;
    Args a{};
    for (int i = 0; i < 15; ++i) a.in[i] = (const float*)d_in[i];
    a.out = (float*)d_out; a.ws = (unsigned char*)d_ws;
#if N_LAUNCH_MODE == 1
    a.ph_lo = 0; a.ph_hi = N_PHASES;
    hipLaunchKernelGGL(hybrid_fwd, dim3(grid), dim3(NTHR), LDS_BYTES, stream, a);
#else
    for (int k = 0; k < N_PHASES; ++k) { a.ph_lo = k; a.ph_hi = k + 1; hipLaunchKernelGGL(hybrid_fwd, dim3(grid), dim3(NTHR), LDS_BYTES, stream, a); }
#endif
}
```

```cpp
#include <hip/hip_runtime.h>
#include <cstdio>
#include <cstdint>
namespace pg8 {
#define PG8_LAS __attribute__((address_space(3)))
typedef unsigned short bf16_t;
typedef short bf16x8 __attribute__((ext_vector_type(8)));
typedef float f32x4 __attribute__((ext_vector_type(4)));
typedef unsigned u32x4 __attribute__((ext_vector_type(4)));
constexpr int BM = 256, BK = 64, HALF = 128, HTB = HALF * BK * 2  , STAGE_BYTES = 8 * HTB, NXCD = 8, WGM = 8;

__host__ __device__ __forceinline__ int lds_byte(int r, int c) { const int st = (r >> 4) * 2 + (c >> 5), rr = r & 15, cc = c & 31, ob = rr * 64 + cc * 2; return st * 1024 + (ob ^ (((ob >> 9) & 1) << 5)); }
__host__ __device__ __forceinline__ void stage_rc(int b, int& R, int& C) { const int st = b / 1024, sb = b % 1024, swz = sb ^ (((sb >> 9) & 1) << 5); R = (st >> 1) * 16 + swz / 64; C = (st & 1) * 32 + (swz % 64) / 2; }
__host__ __device__ __forceinline__ int perm32(int rho) { const int n = rho >> 4, i = rho & 15; return 8 * (i >> 2) + 4 * n + (i & 3); }

struct Unit { int pm, pn; };
struct Gemm { const bf16_t* A; const bf16_t* Bt; int M, N, K; };

struct StaticOrder {
    int nM, nN, nwg, G, c;
    __host__ __device__ void init(int M, int N, int G_, int c_) { nM = M / BM; nN = N / BM; nwg = nM * nN; G = G_; c = c_; }
    __host__ __device__ bool next(int i, Unit& u) const {
        const long L = (long)i * G + c; if (L >= nwg) return false;
        int wgid = (int)L; { const int q = nwg / NXCD, r = nwg % NXCD, xcd = wgid % NXCD, off = wgid / NXCD; wgid = (xcd < r ? xcd * (q + 1) : r * (q + 1) + (xcd - r) * q) + off; }
        const int nig = WGM * nN, gid = wgid / nig, fm = gid * WGM, gsz = (nM - fm) < WGM ? (nM - fm) : WGM;
        u.pm = fm + ((wgid % nig) % gsz); u.pn = (wgid % nig) / gsz; return true;
    }
    __device__ __forceinline__ void a_ready(const Unit&) const {}
    __device__ __forceinline__ void done(const Unit&) const {}
};

__device__ __forceinline__ unsigned cvt_pk_bf16(float lo, float hi) { unsigned r; asm volatile("v_cvt_pk_bf16_f32 %0, %1, %2" : "=v"(r) : "v"(lo), "v"(hi)); return r; }
typedef float f32x2 __attribute__((ext_vector_type(2)));
__device__ __forceinline__ float silu_f(float x) { return x / (1.0f + __expf(-x)); }
__device__ __forceinline__ float sigm_f(float x) { return 1.0f / (1.0f + __expf(-x)); }
__device__ __forceinline__ u32x4 pack8(const f32x4 a, const f32x4 b) { u32x4 w; w.x = cvt_pk_bf16(a[0], a[1]); w.y = cvt_pk_bf16(a[2], a[3]); w.z = cvt_pk_bf16(b[0], b[1]); w.w = cvt_pk_bf16(b[2], b[3]); return w; }
struct EpiNsaProj {
    static constexpr bool PERM = true, AFTER_DRAIN = false;
    const float* rss; bf16_t* Q; bf16_t* KV; bf16_t* Z; float* GT;
    __device__ __forceinline__ void operator()(const f32x4 (&acc)[2][2][4][2], const Unit& u, int wr, int wc, int fr, int fq) const {
        const int row0 = u.pm * BM + wr * 64 + fr, cl = wc * 32 + 8 * fq, pn = u.pn;
#pragma unroll
        for (int ai = 0; ai < 2; ++ai)
#pragma unroll
            for (int m = 0; m < 4; ++m) {
                const int row = row0 + ai * HALF + m * 16;
                const float rs = rsqrtf(rss[row] * (1.0f / 1024.0f) + 1e-6f);
#pragma unroll
                for (int bj = 0; bj < 2; ++bj) {
                    const int c = bj * HALF + cl;
                    f32x4 v0 = acc[ai][bj][m][0] * rs, v1 = acc[ai][bj][m][1] * rs;
                    if (pn < 4) { *(u32x4*)(Q + (size_t)row * 1024 + pn * 256 + c) = pack8(v0, v1); }
                    else if (pn < 10) { const int j = pn - 4, g = c >> 6, d = c & 63, b = row >> 11, s = row & 2047;
                        *(u32x4*)(KV + (size_t)j * (16384 * 256) + ((size_t)((b * 4 + g) * 2048 + s)) * 64 + d) = pack8(v0, v1); }
                    else if (pn < 22) {
#pragma unroll
                        for (int e = 0; e < 4; ++e) { v0[e] = silu_f(v0[e]); v1[e] = silu_f(v1[e]); }
                        *(u32x4*)(Z + (size_t)row * 3072 + (pn - 10) * 256 + c) = pack8(v0, v1); }
                    else if (c < 48) {
#pragma unroll
                        for (int e = 0; e < 4; ++e) { v0[e] = sigm_f(v0[e]); v1[e] = sigm_f(v1[e]); }
                        *(f32x4*)(GT + (size_t)row * 48 + c) = v0; *(f32x4*)(GT + (size_t)row * 48 + c + 4) = v1; }
                }
            }
    }
};
struct EpiRetProj {
    static constexpr bool PERM = true, AFTER_DRAIN = false;
    const float* rss; const float* COS; const float* SIN; bf16_t* Q; bf16_t* K; bf16_t* V; bf16_t* Z;
    __device__ __forceinline__ void operator()(const f32x4 (&acc)[2][2][4][2], const Unit& u, int wr, int wc, int fr, int fq) const {
        const int row0 = u.pm * BM + wr * 64 + fr, cl = wc * 32 + 8 * fq, pn = u.pn;
#pragma unroll
        for (int ai = 0; ai < 2; ++ai)
#pragma unroll
            for (int m = 0; m < 4; ++m) {
                const int row = row0 + ai * HALF + m * 16;
                const float rs = rsqrtf(rss[row] * (1.0f / 1024.0f) + 1e-6f);
                if (pn < 8) {
                    const float sc = pn < 4 ? rs : rs * 0.0625f;
                    const int s = row & 2047;
                    const f32x4 c0 = *(const f32x4*)(COS + s * 128 + cl), c1 = *(const f32x4*)(COS + s * 128 + cl + 4);
                    const f32x4 s0 = *(const f32x4*)(SIN + s * 128 + cl), s1 = *(const f32x4*)(SIN + s * 128 + cl + 4);
                    const f32x4 a0 = acc[ai][0][m][0] * sc, a1 = acc[ai][0][m][1] * sc, b0 = acc[ai][1][m][0] * sc, b1 = acc[ai][1][m][1] * sc;
                    const f32x4 o10 = a0 * c0 - b0 * s0, o11 = a1 * c1 - b1 * s1, o20 = a0 * s0 + b0 * c0, o21 = a1 * s1 + b1 * c1;
                    bf16_t* base = (pn < 4 ? Q : K) + (size_t)row * 1024 + (pn & 3) * 256 + cl;
                    *(u32x4*)(base) = pack8(o10, o11); *(u32x4*)(base + 128) = pack8(o20, o21);
                } else {
#pragma unroll
                    for (int bj = 0; bj < 2; ++bj) {
                        const int c = bj * HALF + cl;
                        f32x4 v0 = acc[ai][bj][m][0] * rs, v1 = acc[ai][bj][m][1] * rs;
                        if (pn < 16) { *(u32x4*)(V + (size_t)row * 2048 + (pn - 8) * 256 + c) = pack8(v0, v1); }
                        else {
#pragma unroll
                            for (int e = 0; e < 4; ++e) { v0[e] = silu_f(v0[e]); v1[e] = silu_f(v1[e]); }
                            *(u32x4*)(Z + (size_t)row * 2048 + (pn - 16) * 256 + c) = pack8(v0, v1); }
                    }
                }
            }
    }
};
struct EpiF32 {
    static constexpr bool PERM = true, AFTER_DRAIN = false;
    float* O; int ldc;
    __device__ __forceinline__ void operator()(const f32x4 (&acc)[2][2][4][2], const Unit& u, int wr, int wc, int fr, int fq) const {
        const int row0 = u.pm * BM + wr * 64 + fr, cl = u.pn * BM + wc * 32 + 8 * fq;
#pragma unroll
        for (int ai = 0; ai < 2; ++ai)
#pragma unroll
            for (int m = 0; m < 4; ++m)
#pragma unroll
                for (int bj = 0; bj < 2; ++bj) { float* p = O + (size_t)(row0 + ai * HALF + m * 16) * ldc + cl + bj * HALF;
                    *(f32x4*)p = acc[ai][bj][m][0]; *(f32x4*)(p + 4) = acc[ai][bj][m][1]; }
    }
};

template <class Epi, class Sched, bool ALIGN_EPI = false, bool SP2 = false>
__device__ __forceinline__ void gemm_phase(PG8_LAS unsigned char* lds, const Gemm g, const Sched& S, const Epi& E) {
    const int tid = threadIdx.x, wid = __builtin_amdgcn_readfirstlane(tid >> 6), lane = tid & 63, wr = wid >> 2, wc = wid & 3, fr = lane & 15, fq = lane >> 4;
    const int K = g.K, nt = K / BK;
    unsigned voffA[2], voffB[2];
#pragma unroll
    for (int i = 0; i < 2; ++i) { int R, C; stage_rc(tid * 16 + i * 8192, R, C); const int Rb = Epi::PERM ? ((R & ~31) + perm32(R & 31)) : R;
        voffA[i] = (unsigned)(R * K + C) * 2u; voffB[i] = (unsigned)(Rb * K + C) * 2u; }
    const size_t kstep = (size_t)(BK * 2);
    const size_t hstep = (size_t)HALF * K * 2;
    const size_t tstep = 2 * hstep;
    const unsigned ldsw = (unsigned)wid * 1024u;
    const int aoff = lds_byte(wr * 64 + fr, fq * 8), boff = lds_byte(wc * 32 + fr, fq * 8);
#define PG8_SA(b, h) (((b) * 2 + (h)) * HTB)
#define PG8_SB(b, h) ((4 + (b) * 2 + (h)) * HTB)
#define PG8_STAGE(bufoff, gbase, voff) do { _Pragma("unroll") for (int _i = 0; _i < 2; ++_i) \
        __builtin_amdgcn_global_load_lds((const unsigned*)((const char*)(gbase) + (voff)[_i]), (PG8_LAS unsigned*)(lds + (bufoff) + ldsw + _i * 8192), 16, 0, 0); } while (0)
#define PG8_LDA(dst, b, h) do { _Pragma("unroll") for (int m = 0; m < 4; ++m) _Pragma("unroll") for (int k = 0; k < 2; ++k) dst[m][k] = *(const PG8_LAS bf16x8*)(lds + PG8_SA(b, h) + aoff + m * 2048 + k * 1024); } while (0)
#define PG8_LDB(dst, b, h) do { _Pragma("unroll") for (int n = 0; n < 2; ++n) _Pragma("unroll") for (int k = 0; k < 2; ++k) dst[n][k] = *(const PG8_LAS bf16x8*)(lds + PG8_SB(b, h) + boff + n * 2048 + k * 1024); } while (0)
#define PG8_MMA(ai, bj, At, Bt) do { __builtin_amdgcn_s_setprio(1); _Pragma("unroll") for (int m = 0; m < 4; ++m) _Pragma("unroll") for (int n = 0; n < 2; ++n) _Pragma("unroll") for (int k = 0; k < 2; ++k) \
        acc[ai][bj][m][n] = __builtin_amdgcn_mfma_f32_16x16x32_bf16(Bt[n][k], At[m][k], acc[ai][bj][m][n], 0, 0, 0); __builtin_amdgcn_s_setprio(0); } while (0)
#define PG8_WAIT_V(n) asm volatile("s_waitcnt vmcnt(" #n ")" ::: "memory")
#define PG8_WAIT_L(n) asm volatile("s_waitcnt lgkmcnt(" #n ")" ::: "memory")
#define PG8_BAR __builtin_amdgcn_s_barrier()
#define PG8_SCHED __builtin_amdgcn_sched_barrier(0)
    Unit cur, nxt; int ui = 0;
    if (!S.next(0, cur)) return;
    f32x4 acc[2][2][4][2];
#pragma unroll
    for (int a = 0; a < 2; ++a)
#pragma unroll
        for (int b = 0; b < 2; ++b)
#pragma unroll
            for (int m = 0; m < 4; ++m)
#pragma unroll
                for (int n = 0; n < 2; ++n) acc[a][b][m][n] = (f32x4){0.f, 0.f, 0.f, 0.f};
    bf16x8 At[4][2], B0[2][2], B1[2][2];
    const char* cA = (const char*)g.A + (size_t)cur.pm * tstep; const char* cB = (const char*)g.Bt + (size_t)cur.pn * tstep;
    S.a_ready(cur);
    if constexpr (SP2) {
        PG8_STAGE(PG8_SB(0, 0), cB, voffB); PG8_STAGE(PG8_SB(0, 1), cB + hstep, voffB); PG8_STAGE(PG8_SA(0, 0), cA, voffA); PG8_STAGE(PG8_SA(0, 1), cA + hstep, voffA);
        if (wr == 1) PG8_BAR;
        PG8_WAIT_V(2); PG8_BAR;
        PG8_STAGE(PG8_SB(1, 0), cB + kstep, voffB); PG8_STAGE(PG8_SA(1, 0), cA + kstep, voffA); PG8_STAGE(PG8_SB(1, 1), cB + hstep + kstep, voffB);
        PG8_WAIT_V(6); PG8_BAR;
    } else {
        PG8_STAGE(PG8_SB(0, 0), cB, voffB); PG8_STAGE(PG8_SA(0, 0), cA, voffA); PG8_STAGE(PG8_SB(0, 1), cB + hstep, voffB); PG8_STAGE(PG8_SA(0, 1), cA + hstep, voffA);
        if (wr == 1) PG8_BAR;
        PG8_WAIT_V(4); PG8_BAR;
        PG8_STAGE(PG8_SB(1, 0), cB + kstep, voffB); PG8_STAGE(PG8_SA(1, 0), cA + kstep, voffA); PG8_STAGE(PG8_SB(1, 1), cB + hstep + kstep, voffB);
        PG8_WAIT_V(6); PG8_BAR;
    }
    for (;;) {
        const bool has_next = S.next(ui + 1, nxt);
        const char* nA = has_next ? (const char*)g.A + (size_t)nxt.pm * tstep : cA; const char* nB = has_next ? (const char*)g.Bt + (size_t)nxt.pn * tstep : cB;
        for (int t = 0; t < nt; t += 2) {
            const bool last = (t == nt - 2);
            const char* a1 = cA + (size_t)(t + 1) * kstep;
            const char* a2 = last ? nA : cA + (size_t)(t + 2) * kstep; const char* b2 = last ? nB : cB + (size_t)(t + 2) * kstep;
            const char* a3 = a2 + kstep; const char* b3 = b2 + kstep;
            if (last && has_next) S.a_ready(nxt);
            if constexpr (SP2) {
            PG8_LDB(B0, 0, 0); PG8_LDB(B1, 0, 1); PG8_SCHED; PG8_LDA(At, 0, 0); PG8_STAGE(PG8_SA(1, 1), a1 + hstep, voffA);
            PG8_WAIT_V(8); PG8_WAIT_L(0); PG8_BAR; PG8_MMA(0, 0, At, B0); PG8_MMA(0, 1, At, B1); PG8_BAR; PG8_SCHED;
            PG8_LDA(At, 0, 1); PG8_STAGE(PG8_SB(0, 0), b2, voffB); PG8_STAGE(PG8_SB(0, 1), b2 + hstep, voffB); PG8_STAGE(PG8_SA(0, 0), a2, voffA);
            PG8_WAIT_V(8); PG8_WAIT_L(0); PG8_BAR; PG8_MMA(1, 0, At, B0); PG8_MMA(1, 1, At, B1); PG8_BAR; PG8_SCHED;
            PG8_LDB(B0, 1, 0); PG8_LDB(B1, 1, 1); PG8_SCHED; PG8_LDA(At, 1, 0); PG8_STAGE(PG8_SA(0, 1), a2 + hstep, voffA);
            PG8_WAIT_V(8); PG8_WAIT_L(0); PG8_BAR; PG8_MMA(0, 0, At, B0); PG8_MMA(0, 1, At, B1); PG8_BAR; PG8_SCHED;
            PG8_LDA(At, 1, 1); PG8_STAGE(PG8_SB(1, 0), b3, voffB); PG8_STAGE(PG8_SB(1, 1), b3 + hstep, voffB); PG8_STAGE(PG8_SA(1, 0), a3, voffA);
            PG8_WAIT_V(8); PG8_WAIT_L(0); PG8_BAR; PG8_MMA(1, 0, At, B0); PG8_MMA(1, 1, At, B1); PG8_BAR; PG8_SCHED;
            } else {
            PG8_LDB(B0, 0, 0); PG8_SCHED; PG8_LDA(At, 0, 0); PG8_STAGE(PG8_SA(1, 1), a1 + hstep, voffA);
            PG8_WAIT_L(8); PG8_BAR; PG8_WAIT_L(0); PG8_MMA(0, 0, At, B0); PG8_BAR; PG8_SCHED;
            PG8_LDB(B1, 0, 1); PG8_STAGE(PG8_SB(0, 0), b2, voffB);
            PG8_BAR; PG8_WAIT_L(0); PG8_MMA(0, 1, At, B1); PG8_BAR;
            PG8_LDA(At, 0, 1); PG8_STAGE(PG8_SA(0, 0), a2, voffA);
            PG8_BAR; PG8_WAIT_L(0); PG8_MMA(1, 0, At, B0); PG8_BAR; PG8_SCHED;
            PG8_STAGE(PG8_SB(0, 1), b2 + hstep, voffB);
            PG8_WAIT_V(6); PG8_BAR; PG8_MMA(1, 1, At, B1); PG8_BAR;
            PG8_LDB(B0, 1, 0); PG8_SCHED; PG8_LDA(At, 1, 0); PG8_STAGE(PG8_SA(0, 1), a2 + hstep, voffA);
            PG8_WAIT_L(8); PG8_BAR; PG8_WAIT_L(0); PG8_MMA(0, 0, At, B0); PG8_BAR; PG8_SCHED;
            PG8_LDB(B1, 1, 1); PG8_STAGE(PG8_SB(1, 0), b3, voffB);
            PG8_BAR; PG8_WAIT_L(0); PG8_MMA(0, 1, At, B1); PG8_BAR;
            PG8_LDA(At, 1, 1); PG8_STAGE(PG8_SA(1, 0), a3, voffA);
            PG8_BAR; PG8_WAIT_L(0); PG8_MMA(1, 0, At, B0); PG8_BAR; PG8_SCHED;
            PG8_STAGE(PG8_SB(1, 1), b3 + hstep, voffB);
            PG8_WAIT_V(6); PG8_BAR; PG8_MMA(1, 1, At, B1); PG8_BAR;
            }
        }
        if constexpr (ALIGN_EPI) { if (wr == 0) PG8_BAR; }
        if constexpr (!Epi::AFTER_DRAIN) { E(acc, cur, wr, wc, fr, fq); S.done(cur); }
        if (!has_next) break;
#pragma unroll
        for (int a = 0; a < 2; ++a)
#pragma unroll
            for (int b = 0; b < 2; ++b)
#pragma unroll
                for (int m = 0; m < 4; ++m)
#pragma unroll
                    for (int n = 0; n < 2; ++n) acc[a][b][m][n] = (f32x4){0.f, 0.f, 0.f, 0.f};
        cur = nxt; cA = nA; cB = nB; ++ui;
        if constexpr (ALIGN_EPI) { if (wr == 1) PG8_BAR; }
    }
    PG8_WAIT_V(0);
    if constexpr (!ALIGN_EPI) { if (wr == 0) PG8_BAR; }
    PG8_BAR;
    if constexpr (Epi::AFTER_DRAIN) { E.fused(acc, cur, wr, wc, fr, fq, lds, wid, lane); S.done(cur); }
#undef PG8_SA
#undef PG8_SB
#undef PG8_STAGE
#undef PG8_LDA
#undef PG8_LDB
#undef PG8_MMA
#undef PG8_WAIT_V
#undef PG8_WAIT_L
#undef PG8_BAR
#undef PG8_SCHED
}
}
constexpr int NWAVES = 8, NTHR = 512;
constexpr int BATCH = 8, S = 2048, D = 1024, M = BATCH * S;
constexpr int NSA_NP = 5888, RET_NP = 6144;
constexpr int NCMP = 127;
constexpr float RMS_EPS = 1e-6f, GN_EPS = 1e-6f;
constexpr size_t MiB = 1u << 20;
constexpr size_t WS_CTL = 0, CTL_ZERO_BYTES = 1 * MiB;
constexpr size_t WS_COS = 1 * MiB, WS_SIN = 2 * MiB;
constexpr size_t WS_WIN = 4 * MiB;
constexpr size_t WS_WOUT = 16 * MiB;
constexpr size_t WS_HB = 24 * MiB;
constexpr size_t WS_ACT = 56 * MiB;
constexpr size_t NSA_Q = WS_ACT, NSA_KV = WS_ACT + 32 * MiB, NSA_Z = WS_ACT + 80 * MiB, NSA_GT = WS_ACT + 176 * MiB, NSA_KC = WS_ACT + 179 * MiB, NSA_VC = WS_ACT + 180 * MiB;
constexpr size_t NSA_YO = NSA_Z;
constexpr size_t RET_Q = WS_ACT, RET_K = WS_ACT + 32 * MiB, RET_V = WS_ACT + 64 * MiB, RET_Z = WS_ACT + 128 * MiB;
constexpr size_t RET_YO = RET_Q;
constexpr size_t WS_END = WS_ACT + 192 * MiB;
static_assert(WS_END <= 256 * MiB, "d_ws map");
constexpr int CW_TMO = 0, CW_CODE = 1;
constexpr int CW_BAR = 4096;
constexpr int CW_RSS = 16384;
static_assert((CW_RSS + 5 * 16384) * 4 <= (int)CTL_ZERO_BYTES, "CTL words inside the memset region");
constexpr int RING_OFF = 0, RING_BYTES = 131072;
constexpr int LDSCTL_OFF = RING_BYTES, MISC_OFF = LDSCTL_OFF + 320;
constexpr int LDS_BYTES = 147456;
#define GAS __attribute__((address_space(1)))
#define LAS __attribute__((address_space(3)))
typedef unsigned short bf16;
typedef unsigned v4u __attribute__((ext_vector_type(4)));
typedef float f32x4 __attribute__((ext_vector_type(4)));
typedef GAS unsigned gu32;
#define RLX_AGENT __ATOMIC_RELAXED, __HIP_MEMORY_SCOPE_AGENT
#define LDS_WAIT() asm volatile("s_waitcnt lgkmcnt(0)" ::: "memory")
#define VM_WAIT() asm volatile("s_waitcnt vmcnt(0)" ::: "memory")
__device__ __forceinline__ unsigned f2bf(float f) { unsigned u = __builtin_bit_cast(unsigned, f); return (u + 0x7fffu + ((u >> 16) & 1u)) >> 16; }
__device__ __forceinline__ unsigned pk2(float lo, float hi) { return f2bf(lo) | (f2bf(hi) << 16); }
__device__ __forceinline__ float bf2f(unsigned short b) { return __builtin_bit_cast(float, (unsigned)b << 16); }
__device__ __forceinline__ float bflo(unsigned w) { return __builtin_bit_cast(float, w << 16); }
__device__ __forceinline__ float bfhi(unsigned w) { return __builtin_bit_cast(float, w & 0xffff0000u); }
__device__ __forceinline__ float wave_sum(float v) {
#pragma unroll
    for (int o = 1; o < 64; o <<= 1) v += __shfl_xor(v, o);
    return v;
}
__device__ __forceinline__ float wave_max(float v) {
#pragma unroll
    for (int o = 1; o < 64; o <<= 1) v = fmaxf(v, __shfl_xor(v, o));
    return v;
}
#define XB_TMO      128
#define XB_XCNT(j)  (256  + 64 * (j))
#define XB_XSUB(j)  (1280 + 64 * (j))
#define XB_XGEN(j)  (2304 + 64 * (j))
#define XB_TOP      3328
#define XB_TOPGEN   3392
#define XCD_BAR_WORDS 3456
#define XB_SPIN_CAP (1u << 18)

__device__ __forceinline__ unsigned xb_ld(unsigned* p)              { return __hip_atomic_load(p, __ATOMIC_RELAXED, __HIP_MEMORY_SCOPE_AGENT); }
__device__ __forceinline__ unsigned xb_add(unsigned* p, unsigned v) { return __hip_atomic_fetch_add(p, v, __ATOMIC_RELAXED, __HIP_MEMORY_SCOPE_AGENT); }
__device__ __forceinline__ unsigned xb_xcc_id() { return (unsigned)__builtin_amdgcn_s_getreg((3 << 11) | 20) & 0xFu; }
#define XB_SPIN(cond, bar) do { unsigned _sp = 0; while (cond) { __builtin_amdgcn_s_sleep(1); \
    if ((++_sp & 255u) == 0u) { if (xb_ld(&(bar)[XB_TMO])) break; if (_sp > XB_SPIN_CAP) { atomicAdd(&(bar)[XB_TMO], 1u); break; } } } } while (0)

struct XcdBarrier {
    unsigned* bar; unsigned x;
    volatile LAS unsigned* st;
};

__device__ __forceinline__ XcdBarrier xcd_barrier_post(unsigned* bar, volatile LAS unsigned* st) {
    XcdBarrier b; b.bar = bar; b.x = xb_xcc_id(); b.st = st;
    if (threadIdx.x == 0) (void)xb_add(&bar[XB_XCNT(b.x)], 1u);
    return b;
}
__device__ __forceinline__ void xcd_barrier_complete(unsigned* bar, unsigned x, unsigned& nloc, unsigned& nx) {
    const unsigned G = gridDim.x * gridDim.y * gridDim.z;
    unsigned sum, cnt, mine, sp = 0u;
    for (;;) {
        sum = 0u; cnt = 0u; mine = 0u;
#pragma unroll
        for (unsigned j = 0; j < 16; ++j) { const unsigned c = xb_ld(&bar[XB_XCNT(j)]); sum += c; cnt += (c > 0u) ? 1u : 0u; mine = (j == x) ? c : mine; }
        if (sum == G) break;
        __builtin_amdgcn_s_sleep(1);
        if ((++sp & 255u) == 0u) { if (xb_ld(&bar[XB_TMO])) break; if (sp > XB_SPIN_CAP) { atomicAdd(&bar[XB_TMO], 1u); break; } }
    }
    nloc = mine > 0u ? mine : 1u; nx = cnt > 0u ? cnt : 1u;
}

__device__ __forceinline__ void xcd_barrier(const XcdBarrier& b) {
    asm volatile("s_waitcnt vmcnt(0)" ::: "memory");
    __syncthreads();
    if (threadIdx.x == 0) {
        unsigned* bar = b.bar;
        __builtin_amdgcn_s_waitcnt(0);
        unsigned nloc = b.st[0], nx = b.st[1];
        if (nloc == 0u) { xcd_barrier_complete(bar, b.x, nloc, nx); b.st[0] = nloc; b.st[1] = nx; }
        const unsigned old = xb_add(&bar[XB_XSUB(b.x)], 1u);
        const unsigned gen = old / nloc;
        if (old + 1u == (gen + 1u) * nloc) {
            __builtin_amdgcn_fence(__ATOMIC_RELEASE, "agent");
            asm volatile("s_waitcnt vmcnt(0)" ::: "memory");
            const unsigned og = xb_add(&bar[XB_TOP], 1u);
            const unsigned tg = og / nx;
            if (og + 1u == (tg + 1u) * nx) xb_add(&bar[XB_TOPGEN], 1u);
            else XB_SPIN(xb_ld(&bar[XB_TOPGEN]) == tg, bar);
            __builtin_amdgcn_fence(__ATOMIC_ACQUIRE, "agent");
            xb_add(&bar[XB_XGEN(b.x)], 1u);
            asm volatile("s_waitcnt vmcnt(0)" ::: "memory");
        } else {
            XB_SPIN(xb_ld(&bar[XB_XGEN(b.x)]) == gen, bar);
            __builtin_amdgcn_fence(__ATOMIC_ACQUIRE, "agent");
            asm volatile("s_waitcnt vmcnt(0)" ::: "memory");
        }
    }
    __syncthreads();
}

struct Ctx { LAS unsigned char* lds; int tid, lane, wave, vcu, G; const float* in[15]; float* out; unsigned char* ws; };
enum { IN_X = 0, IN_PRE, IN_POST, IN_TAB, IN_NWIN, IN_NWOUT, IN_KPOS, IN_KW1, IN_KW2, IN_VPOS, IN_VW1, IN_VW2, IN_RWIN, IN_RWOUT, IN_GN };

__device__ __forceinline__ int t5_bucket(int d) { int r = 16 + (int)((16.0f / 3.0f) * (__log2f((float)(d < 1 ? 1 : d)) - 4.0f)); r = r > 31 ? 31 : r; return d < 16 ? d : r; }

__device__ __forceinline__ int nsa_src_col(int n) { return n < 2560 ? n : (n < 5632 ? n + 48 : (n < 5680 ? n - 3072 : -1)); }
template <int MODE> __device__ __forceinline__ void convert_item(const float* W, int K, int Nsrc, const float* gain, bf16* WT, LAS float* scr, int item, int nblk, int lane) {
    const int kb = item / nblk, nb = item % nblk, k0 = 64 * kb, n0 = 32 * nb;
    const int n = n0 + (lane & 31), sc = MODE == 1 ? nsa_src_col(n) : n;
#pragma unroll 8
    for (int i = 0; i < 32; ++i) { const int kk = 2 * i + (lane >> 5); float v = 0.f;
        if (sc >= 0) { v = W[(size_t)(k0 + kk) * Nsrc + sc]; if (gain) v *= gain[k0 + kk]; }
        scr[kk * 33 + (lane & 31)] = v; }
    LDS_WAIT();
    const int c = lane & 7;
#pragma unroll
    for (int j = 0; j < 4; ++j) { const int nn = (lane >> 3) + 8 * j; const LAS float* s = scr + (8 * c) * 33 + nn;
        v4u o; o.x = pk2(s[0 * 33], s[1 * 33]); o.y = pk2(s[2 * 33], s[3 * 33]); o.z = pk2(s[4 * 33], s[5 * 33]); o.w = pk2(s[6 * 33], s[7 * 33]);
        *(v4u*)(WT + (size_t)(n0 + nn) * K + k0 + 8 * c) = o; }
    LDS_WAIT();
}
template <int MODE> __device__ __forceinline__ void convert_weights(const Ctx& C, const float* W, int K, int Nsrc, int Ndst, const float* gain, bf16* WT) {
    LAS float* scr = (LAS float*)(C.lds + C.wave * 16384);
    const int gw = C.vcu * NWAVES + C.wave, NGW = C.G * NWAVES, nblk = Ndst / 32, nitems = (K / 64) * nblk;
    for (int it = gw; it < nitems; it += NGW) convert_item<MODE>(W, K, Nsrc, gain, WT, scr, it, nblk, C.lane);
}

__device__ __forceinline__ void p0_rows(const Ctx& C) {
    const int gw = C.vcu * NWAVES + C.wave, NGW = C.G * NWAVES;
    bf16* HB = (bf16*)(C.ws + WS_HB); float* rss = (float*)(C.ws + WS_CTL) + CW_RSS;
    for (int m = gw; m < M; m += NGW) {
        const f32x4* xr = (const f32x4*)(C.in[IN_X] + (size_t)m * D) + C.lane; f32x4 v[4]; float s = 0.f;
#pragma unroll
        for (int j = 0; j < 4; ++j) { v[j] = xr[64 * j]; s += (v[j].x * v[j].x + v[j].y * v[j].y) + (v[j].z * v[j].z + v[j].w * v[j].w); }
        s = wave_sum(s);
        unsigned long long* o8 = (unsigned long long*)(HB + (size_t)m * D) + C.lane;
#pragma unroll
        for (int j = 0; j < 4; ++j) o8[64 * j] = (unsigned long long)pk2(v[j].x, v[j].y) | ((unsigned long long)pk2(v[j].z, v[j].w) << 32);
        if (C.lane == 0) rss[m] = s;
    }
}
__device__ __forceinline__ void p0_tables(const Ctx& C) {
    float* COS = (float*)(C.ws + WS_COS); float* SIN = (float*)(C.ws + WS_SIN);
    for (int idx = C.vcu * NTHR + C.tid; idx < S * 128; idx += C.G * NTHR) {
        const int s = idx >> 7, i = idx & 127;
        const float inv = (float)(1.0 / exp2((double)i * (13.287712379549449 / 127.0)));
        const float ang = (float)s * inv;
        double rev = (double)ang * 0.15915494309189535; rev -= floor(rev + 0.5);
        const float rf = (float)rev;
        COS[idx] = __builtin_amdgcn_cosf(rf); SIN[idx] = __builtin_amdgcn_sinf(rf);
    }
}

__device__ __forceinline__ void naive_compress(const Ctx& C, int slot) {
    LAS float* xs = (LAS float*)(C.lds);
    LAS float* hid = (LAS float*)(C.lds + 32768);
    const bf16* KV = (const bf16*)(C.ws + NSA_KV);
    if (C.vcu == 0) for (int i = C.tid; i < 2 * 32 * 64; i += NTHR) { const int kv = i >> 11, bg = (i >> 6) & 31, d = i & 63;
        ((bf16*)(C.ws + (kv ? NSA_VC : NSA_KC)))[((size_t)bg * 128 + 127) * 64 + d] = 0; }
    for (int unit = C.vcu; unit < 2 * BATCH * NCMP; unit += C.G) {
        const int kv = unit / (BATCH * NCMP), rem = unit % (BATCH * NCMP), b = rem / NCMP, c = rem % NCMP;
        const float* pos = C.in[kv ? IN_VPOS : IN_KPOS] + (size_t)slot * 2048;
        const float* w1 = C.in[kv ? IN_VW1 : IN_KW1] + (size_t)slot * 2048 * 256;
        const float* w2 = C.in[kv ? IN_VW2 : IN_KW2] + (size_t)slot * 256 * 64;
        const bf16* src = KV + (size_t)kv * (16384 * 256);
        bf16* dst = (bf16*)(C.ws + (kv ? NSA_VC : NSA_KC));
        for (int idx = C.tid; idx < 8192; idx += NTHR) { const int g = idx >> 11, k = idx & 2047;
            xs[idx] = bf2f(src[((size_t)((b * 4 + g) * 2048 + 16 * c)) * 64 + k]) + pos[k]; }
        __syncthreads();
        { const int j = C.tid & 255, hf = C.tid >> 8; float a0 = 0.f, a1 = 0.f;
          const LAS float* x0 = xs + (2 * hf) * 2048; const LAS float* x1 = x0 + 2048;
#pragma unroll 4
          for (int k = 0; k < 2048; ++k) { const float w = w1[(size_t)k * 256 + j]; a0 += x0[k] * w; a1 += x1[k] * w; }
          hid[(2 * hf) * 256 + j] = a0 / (1.0f + __expf(-a0)); hid[(2 * hf + 1) * 256 + j] = a1 / (1.0f + __expf(-a1)); }
        __syncthreads();
        if (C.tid < 256) { const int g = C.tid >> 6, d = C.tid & 63; float a = 0.f;
#pragma unroll 4
            for (int j = 0; j < 256; ++j) a += hid[g * 256 + j] * w2[j * 64 + d];
            dst[((size_t)((b * 4 + g) * 128 + c)) * 64 + d] = (bf16)f2bf(a); }
        __syncthreads();
    }
}

__device__ __forceinline__ float dot64(const LAS float* q, const bf16* krow) {
    const v4u* kp = (const v4u*)krow; float s = 0.f;
#pragma unroll
    for (int c = 0; c < 8; ++c) { const v4u w = kp[c]; const LAS float* qq = q + c * 8;
        s += qq[0] * bflo(w.x) + qq[1] * bfhi(w.x) + qq[2] * bflo(w.y) + qq[3] * bfhi(w.y) + qq[4] * bflo(w.z) + qq[5] * bfhi(w.z) + qq[6] * bflo(w.w) + qq[7] * bfhi(w.w); }
    return s;
}
struct SoftAcc { float m, l, o; };
__device__ __forceinline__ void attn_block(SoftAcc& a, const LAS float* q, LAS float* pw, const bf16* Kblk, const bf16* Vblk, float bias, bool valid, int lane) {
    const float lg = valid ? dot64(q, Kblk + lane * 64) * 0.125f + bias : -1e30f;
    const float bm = wave_max(lg);
    if (bm <= -1e29f) return;
    const float mn = fmaxf(a.m, bm), sc = __expf(a.m - mn), p = valid ? __expf(lg - mn) : 0.f;
    a.l = a.l * sc + wave_sum(p); a.o *= sc; a.m = mn;
    pw[lane] = p; LDS_WAIT();
    float o = a.o;
#pragma unroll 8
    for (int k = 0; k < 64; ++k) o += pw[k] * bf2f(Vblk[k * 64 + lane]);
    a.o = o; LDS_WAIT();
}
__device__ __forceinline__ void naive_nsa_attn(const Ctx& C) {
    LAS float* lut = (LAS float*)(C.lds);
    LAS float* qs = (LAS float*)(C.lds + 8448);
    LAS float* pc = (LAS float*)(C.lds + 10496);
    LAS float* pwA = (LAS float*)(C.lds + 14592);
    const float* tab = C.in[IN_TAB];
    for (int i = C.tid; i < 16 * 129; i += NTHR) { const int h = i / 129, d = i % 129; lut[i] = tab[t5_bucket(d) * 16 + h]; }
    __syncthreads();
    bf16* Q = (bf16*)(C.ws + NSA_Q); const bf16* KV = (const bf16*)(C.ws + NSA_KV); const bf16* Z = (const bf16*)(C.ws + NSA_Z); const float* GT = (const float*)(C.ws + NSA_GT);
    const bf16* KC = (const bf16*)(C.ws + NSA_KC); const bf16* VC = (const bf16*)(C.ws + NSA_VC);
    const int w = C.wave, lane = C.lane;
    LAS float* q = qs + w * 64; LAS float* pw = pwA + w * 64; LAS float* pcw = pc + w * 128;
    for (int unit = C.vcu; unit < BATCH * S * 2; unit += C.G) {
        const int b = unit >> 12, rem = unit & 4095, t = rem >> 1, gp = rem & 1, g = gp * 2 + (w >> 2), h = g * 4 + (w & 3);
        const int row = b * S + t;
        const LAS float* lh = lut + h * 129;
        q[lane] = bf2f(Q[(size_t)row * 1024 + h * 64 + lane]); LDS_WAIT();
        const size_t gofs = (size_t)(b * 4 + g);
        float o_cmp;
        { const bf16* KCb = KC + gofs * 128 * 64; const bf16* VCb = VC + gofs * 128 * 64;
          const int e0 = 16 * lane + 31, e1 = 16 * (64 + lane) + 31; const bool v0 = e0 <= t, v1 = (lane < 63) && (e1 <= t);
          const int d0 = t - e0, d1 = t - e1;
          const float lg0 = v0 ? dot64(q, KCb + lane * 64) * 0.125f + lh[d0 > 128 ? 128 : (d0 < 0 ? 0 : d0)] : -1e30f;
          const float lg1 = v1 ? dot64(q, KCb + (64 + lane) * 64) * 0.125f + lh[d1 > 128 ? 128 : (d1 < 0 ? 0 : d1)] : -1e30f;
          const float mx = wave_max(fmaxf(lg0, lg1));
          float p0 = v0 ? __expf(lg0 - mx) : 0.f, p1 = v1 ? __expf(lg1 - mx) : 0.f;
          const float l = wave_sum(p0 + p1), inv = l > 0.f ? 1.0f / l : 0.f;
          p0 *= inv; p1 *= inv; pcw[lane] = p0; pcw[64 + lane] = p1; LDS_WAIT();
          float o = 0.f;
#pragma unroll 8
          for (int c = 0; c < NCMP; ++c) o += pcw[c] * bf2f(VCb[c * 64 + lane]);
          o_cmp = o; }
        __syncthreads();
        unsigned selmask;
        { const int j = lane & 31, cur = t >> 6; float imp = 0.f; const LAS float* pg = pc + (w & 4) * 128;
          const int clo = 4 * j - 1 < 0 ? 0 : 4 * j - 1, chi = 4 * j + 3 > 126 ? 126 : 4 * j + 3;
          for (int r = 0; r < 4; ++r) for (int c = clo; c <= chi; ++c) imp += pg[r * 128 + c];
          const bool valid = j <= cur, forced = (j == 0) || (j == cur) || (j == cur - 1);
          const float score = valid ? imp + (forced ? 1000.0f : 0.f) : -1e30f;
          int rank = 0;
          for (int i = 0; i < 32; ++i) { const float si = __shfl(score, i); rank += ((si > score) || (si == score && i < j)) ? 1 : 0; }
          selmask = (unsigned)(__ballot(rank < 16) & 0xffffffffull); }
        __syncthreads();
        const int cur = t >> 6;
        SoftAcc as{-1e30f, 0.f, 0.f};
        { const bf16* Kb = KV + (size_t)2 * (16384 * 256) + gofs * 2048 * 64; const bf16* Vb = KV + (size_t)3 * (16384 * 256) + gofs * 2048 * 64;
          for (int j = 0; j <= cur; ++j) if ((selmask >> j) & 1u) { const int pos = 64 * j + lane, dist = t - pos;
              attn_block(as, q, pw, Kb + (size_t)j * 4096, Vb + (size_t)j * 4096, lh[dist > 128 ? 128 : (dist < 0 ? 0 : dist)], dist >= 0, lane); } }
        SoftAcc aw{-1e30f, 0.f, 0.f};
        { const bf16* Kb = KV + (size_t)4 * (16384 * 256) + gofs * 2048 * 64; const bf16* Vb = KV + (size_t)5 * (16384 * 256) + gofs * 2048 * 64;
          const int jlo = (t - 511 < 0 ? 0 : t - 511) >> 6;
          for (int j = jlo; j <= cur; ++j) { const int pos = 64 * j + lane, dist = t - pos;
              attn_block(aw, q, pw, Kb + (size_t)j * 4096, Vb + (size_t)j * 4096, lh[dist > 128 ? 128 : (dist < 0 ? 0 : dist)], dist >= 0 && dist < 512, lane); } }
        const float o_slc = as.l > 0.f ? as.o / as.l : 0.f, o_win = aw.l > 0.f ? aw.o / aw.l : 0.f;
        const float* gt = GT + (size_t)row * 48; const bf16* zr = Z + (size_t)row * 3072 + h * 64 + lane;
        const float y = gt[h] * o_cmp * bf2f(zr[0]) + gt[16 + h] * o_slc * bf2f(zr[1024]) + gt[32 + h] * o_win * bf2f(zr[2048]);
        Q[(size_t)row * 1024 + h * 64 + lane] = (bf16)f2bf(y);
    }
}

__device__ __forceinline__ void naive_retention(const Ctx& C, int slot) {
    LAS float* qs = (LAS float*)(C.lds);
    LAS float* as = (LAS float*)(C.lds + 8192);
    LAS float* red = (LAS float*)(C.lds + 8192 + 65536);
    const bf16* Qr = (const bf16*)(C.ws + RET_Q); const bf16* Kr = (const bf16*)(C.ws + RET_K); const bf16* Vr = (const bf16*)(C.ws + RET_V); bf16* Zr = (bf16*)(C.ws + RET_Z);
    const float* gn = C.in[IN_GN] + (size_t)slot * 2048;
    const int tid = C.tid, lane = C.lane, w = C.wave;
    for (int unit = C.vcu; unit < BATCH * 4 * 256; unit += C.G) {
        const int b = unit >> 10, h = (unit >> 8) & 3, t0 = (unit & 255) * 8, tmax = t0 + 7;
        for (int idx = tid; idx < 2048; idx += NTHR) { const int i = idx >> 8, d = idx & 255; qs[idx] = bf2f(Qr[(size_t)(b * S + t0 + i) * 1024 + h * 256 + d]); }
        __syncthreads();
        const float lg = __log2f(1.0f - exp2f(-5.0f - (float)h));
        for (int s = tid; s <= tmax; s += NTHR) {
            const v4u* kp = (const v4u*)(Kr + (size_t)(b * S + s) * 1024 + h * 256);
            float acc[8];
#pragma unroll
            for (int i = 0; i < 8; ++i) acc[i] = 0.f;
#pragma unroll 2
            for (int c = 0; c < 32; ++c) { const v4u kw = kp[c];
                const float k0 = bflo(kw.x), k1 = bfhi(kw.x), k2 = bflo(kw.y), k3 = bfhi(kw.y), k4 = bflo(kw.z), k5 = bfhi(kw.z), k6 = bflo(kw.w), k7 = bfhi(kw.w);
#pragma unroll
                for (int i = 0; i < 8; ++i) { const LAS float* qq = qs + i * 256 + c * 8;
                    acc[i] += qq[0] * k0 + qq[1] * k1 + qq[2] * k2 + qq[3] * k3 + qq[4] * k4 + qq[5] * k5 + qq[6] * k6 + qq[7] * k7; } }
#pragma unroll
            for (int i = 0; i < 8; ++i) { const int dist = t0 + i - s; as[i * 2048 + s] = dist >= 0 ? acc[i] * exp2f((float)dist * lg) : 0.f; }
        }
        __syncthreads();
        float o[8];
#pragma unroll
        for (int i = 0; i < 8; ++i) o[i] = 0.f;
        { const bf16* vp = Vr + (size_t)(b * S) * 2048 + h * 512 + tid;
#pragma unroll 4
          for (int s = 0; s <= tmax; ++s) { const float vv = bf2f(vp[(size_t)s * 2048]);
#pragma unroll
              for (int i = 0; i < 8; ++i) o[i] += as[i * 2048 + s] * vv; } }
        float mu[8];
#pragma unroll
        for (int i = 0; i < 8; ++i) { const float sm = wave_sum(o[i]); if (lane == 0) red[w * 8 + i] = sm; }
        __syncthreads();
#pragma unroll
        for (int i = 0; i < 8; ++i) { float sm = 0.f;
#pragma unroll
            for (int ww = 0; ww < 8; ++ww) sm += red[ww * 8 + i];
            mu[i] = sm * (1.0f / 512.0f); }
        __syncthreads();
#pragma unroll
        for (int i = 0; i < 8; ++i) { const float d = o[i] - mu[i]; const float sq = wave_sum(d * d); if (lane == 0) red[w * 8 + i] = sq; }
        __syncthreads();
#pragma unroll
        for (int i = 0; i < 8; ++i) { float sq = 0.f;
#pragma unroll
            for (int ww = 0; ww < 8; ++ww) sq += red[ww * 8 + i];
            const float rstd = rsqrtf(sq * (1.0f / 512.0f) + GN_EPS);
            const size_t idx = (size_t)(b * S + t0 + i) * 2048 + h * 512 + tid;
            Zr[idx] = (bf16)f2bf((o[i] - mu[i]) * rstd * gn[h * 512 + tid] * bf2f(Zr[idx])); }
        __syncthreads();
    }
}

__device__ __forceinline__ void naive_norm_res(const Ctx& C, int layer, const float* YO) {
    const int gw = C.vcu * NWAVES + C.wave, NGW = C.G * NWAVES;
    bf16* HB = (bf16*)(C.ws + WS_HB); float* rss = (float*)(C.ws + WS_CTL) + CW_RSS + (size_t)(layer + 1) * 16384;
    const float* hp = layer == 0 ? C.in[IN_X] : C.out; const float* gain = C.in[IN_POST] + (size_t)layer * D;
    for (int m = gw; m < M; m += NGW) {
        const f32x4* yr = (const f32x4*)(YO + (size_t)m * D) + C.lane; f32x4 v[4]; float s = 0.f;
#pragma unroll
        for (int j = 0; j < 4; ++j) { v[j] = yr[64 * j]; s += (v[j].x * v[j].x + v[j].y * v[j].y) + (v[j].z * v[j].z + v[j].w * v[j].w); }
        const float rstd = rsqrtf(wave_sum(s) * (1.0f / 1024.0f) + RMS_EPS);
        const f32x4* hr = (const f32x4*)(hp + (size_t)m * D) + C.lane; const f32x4* gr = (const f32x4*)gain + C.lane;
        f32x4* orow = (f32x4*)(C.out + (size_t)m * D) + C.lane;
        unsigned long long* o8 = (unsigned long long*)(HB + (size_t)m * D) + C.lane; float s2 = 0.f;
#pragma unroll
        for (int j = 0; j < 4; ++j) { const f32x4 hn = hr[64 * j] + v[j] * rstd * gr[64 * j]; orow[64 * j] = hn;
            s2 += (hn.x * hn.x + hn.y * hn.y) + (hn.z * hn.z + hn.w * hn.w);
            o8[64 * j] = (unsigned long long)pk2(hn.x, hn.y) | ((unsigned long long)pk2(hn.z, hn.w) << 32); }
        s2 = wave_sum(s2);
        if (C.lane == 0) rss[m] = s2;
    }
}
namespace nsa {
typedef short bf16x8 __attribute__((ext_vector_type(8)));
typedef short s16x4 __attribute__((ext_vector_type(4)));
typedef float f32x16 __attribute__((ext_vector_type(16)));
constexpr int KB0 = 0, VB0 = 8192, LUT_OFF = 32768, GE_OFF = 49152, SC_OFF = 114688, SELM_OFF = 116736;
constexpr float LOG2E = 1.4426950408889634f, SC2 = 0.125f * 1.4426950408889634f;
constexpr size_t TS = (size_t)16384 * 256;
__device__ __forceinline__ unsigned cvtpk(float lo, float hi) { unsigned r; asm volatile("v_cvt_pk_bf16_f32 %0, %1, %2" : "=v"(r) : "v"(lo), "v"(hi)); return r; }
__device__ __forceinline__ s16x4 vtr(const LAS unsigned char* p) { typedef short v4i16_t __attribute__((ext_vector_type(4))); return __builtin_bit_cast(s16x4, __builtin_amdgcn_ds_read_tr16_b64_v4i16((LAS v4i16_t*)p)); }
__device__ __forceinline__ float xhalf_max(float m) { auto rr = __builtin_amdgcn_permlane32_swap(__float_as_uint(m), __float_as_uint(m), false, false); return fmaxf(__uint_as_float(rr[0]), __uint_as_float(rr[1])); }
__device__ __forceinline__ float xhalf_sum(float m) { auto rr = __builtin_amdgcn_permlane32_swap(__float_as_uint(m), __float_as_uint(m), false, false); return __uint_as_float(rr[0]) + __uint_as_float(rr[1]); }
__device__ __forceinline__ int koff(int i) { return (i & 3) + 8 * (i >> 2); }

struct Soft { float m, l; f32x16 o0, o1; };

__device__ __forceinline__ void attn_tile(Soft& st, const LAS unsigned char* Kb, const LAS unsigned char* Vb, const bf16x8 (&qf)[4], const unsigned (&kof)[4], unsigned vof0, unsigned vof1,
                                          int kind, int base_d, bool sel, const LAS float* lutp, float lut128, LAS float* ge, int gj0, float& alpha_out) {
    f32x16 s0, s1;
#pragma unroll
    for (int i = 0; i < 16; ++i) { s0[i] = 0.f; s1[i] = 0.f; }
#pragma unroll
    for (int ks = 0; ks < 4; ++ks) {
        const bf16x8 a0 = *(const LAS bf16x8*)(Kb + kof[ks]), a1 = *(const LAS bf16x8*)(Kb + kof[ks] + 4096);
        s0 = __builtin_amdgcn_mfma_f32_32x32x16_bf16(a0, qf[ks], s0, 0, 0, 0);
        s1 = __builtin_amdgcn_mfma_f32_32x32x16_bf16(a1, qf[ks], s1, 0, 0, 0);
    }
    const float NEG = -INFINITY;
    if (kind == 0) {
#pragma unroll
        for (int i = 0; i < 16; ++i) { const int d0 = base_d - 16 * koff(i), d1 = d0 - 512;
            const float b0 = lutp[d0 > 128 ? 128 : (d0 < 0 ? 0 : d0)], b1 = lutp[d1 > 128 ? 128 : (d1 < 0 ? 0 : d1)];
            s0[i] = d0 >= 0 ? s0[i] * SC2 + b0 : NEG; s1[i] = d1 >= 0 ? s1[i] * SC2 + b1 : NEG; }
    } else if (kind == 1) {
#pragma unroll
        for (int i = 0; i < 16; ++i) { const int d0 = base_d - koff(i), d1 = d0 - 32;
            const float b0 = lutp[d0 > 128 ? 128 : (d0 < 0 ? 0 : d0)], b1 = lutp[d1 > 128 ? 128 : (d1 < 0 ? 0 : d1)];
            s0[i] = (d0 >= 0 && sel) ? s0[i] * SC2 + b0 : NEG; s1[i] = (d1 >= 0 && sel) ? s1[i] * SC2 + b1 : NEG; }
    } else if (kind == 2) {
        const float cb = sel ? lut128 : NEG;
#pragma unroll
        for (int i = 0; i < 16; ++i) { s0[i] = s0[i] * SC2 + cb; s1[i] = s1[i] * SC2 + cb; }
    } else {
#pragma unroll
        for (int i = 0; i < 16; ++i) { const int d0 = base_d - koff(i), d1 = d0 - 32;
            s0[i] = d0 < 512 ? s0[i] * SC2 + lut128 : NEG; s1[i] = d1 < 512 ? s1[i] * SC2 + lut128 : NEG; }
    }
    float bm = fmaxf(s0[0], s1[0]);
#pragma unroll
    for (int i = 1; i < 16; ++i) bm = fmaxf(bm, fmaxf(s0[i], s1[i]));
    bm = xhalf_max(bm);
    const float mn = fmaxf(st.m, bm), alpha = __builtin_amdgcn_exp2f(st.m - mn);
    st.m = mn; alpha_out = alpha;
    float ps = 0.f;
#pragma unroll
    for (int i = 0; i < 16; ++i) { s0[i] = __builtin_amdgcn_exp2f(s0[i] - mn); s1[i] = __builtin_amdgcn_exp2f(s1[i] - mn); ps += s0[i] + s1[i]; }
    st.l = st.l * alpha + ps;
#pragma unroll
    for (int i = 0; i < 16; ++i) { st.o0[i] *= alpha; st.o1[i] *= alpha; }
    if (ge) {
#pragma unroll
        for (int m4 = 0; m4 < 4; ++m4) {
            ge[gj0 + 2 * m4] = (s0[4 * m4] + s0[4 * m4 + 1]) + (s0[4 * m4 + 2] + s0[4 * m4 + 3]); ge[8192 + gj0 + 2 * m4] = s0[4 * m4 + 3];
            ge[gj0 + 8 + 2 * m4] = (s1[4 * m4] + s1[4 * m4 + 1]) + (s1[4 * m4 + 2] + s1[4 * m4 + 3]); ge[8192 + gj0 + 8 + 2 * m4] = s1[4 * m4 + 3]; }
    }
    bf16x8 pf[4];
#pragma unroll
    for (int sp = 0; sp < 4; ++sp) {
        v4u w;
        if (sp < 2) { w.x = cvtpk(s0[8 * sp], s0[8 * sp + 1]); w.y = cvtpk(s0[8 * sp + 2], s0[8 * sp + 3]); w.z = cvtpk(s0[8 * sp + 4], s0[8 * sp + 5]); w.w = cvtpk(s0[8 * sp + 6], s0[8 * sp + 7]); }
        else { const int q = sp - 2; w.x = cvtpk(s1[8 * q], s1[8 * q + 1]); w.y = cvtpk(s1[8 * q + 2], s1[8 * q + 3]); w.z = cvtpk(s1[8 * q + 4], s1[8 * q + 5]); w.w = cvtpk(s1[8 * q + 6], s1[8 * q + 7]); }
        pf[sp] = __builtin_bit_cast(bf16x8, w);
    }
#pragma unroll
    for (int sp = 0; sp < 4; ++sp) {
        const s16x4 l0 = vtr(Vb + vof0 + 2048 * sp), h0 = vtr(Vb + vof0 + 2048 * sp + 1024), l1 = vtr(Vb + vof1 + 2048 * sp), h1 = vtr(Vb + vof1 + 2048 * sp + 1024);
        const bf16x8 v0 = (bf16x8){l0[0], l0[1], l0[2], l0[3], h0[0], h0[1], h0[2], h0[3]}, v1 = (bf16x8){l1[0], l1[1], l1[2], l1[3], h1[0], h1[1], h1[2], h1[3]};
        st.o0 = __builtin_amdgcn_mfma_f32_32x32x16_bf16(v0, pf[sp], st.o0, 0, 0, 0);
        st.o1 = __builtin_amdgcn_mfma_f32_32x32x16_bf16(v1, pf[sp], st.o1, 0, 0, 0);
    }
}

__device__ __forceinline__ void nsa_attn_phase(const Ctx& C) {
    LAS unsigned char* L = C.lds;
    LAS float* lut2 = (LAS float*)(L + LUT_OFF); LAS float* GE = (LAS float*)(L + GE_OFF); LAS float* SCp = (LAS float*)(L + SC_OFF); LAS unsigned* SELM = (LAS unsigned*)(L + SELM_OFF);
    const float* tab = C.in[IN_TAB];
    for (int i = C.tid; i < 16 * 129; i += NTHR) { const int h = i / 129, d = i % 129; lut2[i] = tab[t5_bucket(d) * 16 + h] * LOG2E; }
    __syncthreads();
    bf16* Q = (bf16*)(C.ws + NSA_Q); const bf16* KV = (const bf16*)(C.ws + NSA_KV); const bf16* Z = (const bf16*)(C.ws + NSA_Z); const float* GT = (const float*)(C.ws + NSA_GT);
    const bf16* KC = (const bf16*)(C.ws + NSA_KC); const bf16* VC = (const bf16*)(C.ws + NSA_VC);
    const int tid = C.tid, w = C.wave, lane = C.lane, c = lane & 31, hh = lane >> 5, r4 = w & 3, th = w >> 2, tok = 32 * th + c;
    unsigned kof[4];
#pragma unroll
    for (int ks = 0; ks < 4; ++ks) kof[ks] = (unsigned)(c * 128 + (((2 * ks + hh) ^ ((c >> 1) & 7)) << 4));
    const int gidx = lane >> 4, q4 = (lane >> 2) & 3, p4 = lane & 3, vb_ = (q4 >> 1) & 1;
    const unsigned vcom = (unsigned)((4 * hh + q4) * 128 + ((2 * (gidx & 1) + (p4 >> 1)) << 4) + (p4 & 1) * 8);
    const unsigned vof0 = vcom + 64u * (unsigned)(0 ^ vb_), vof1 = vcom + 64u * (unsigned)(1 ^ vb_);
    const int srow = tid >> 3, sch = tid & 7;
    const unsigned kst = (unsigned)(srow * 128 + ((sch ^ ((srow >> 1) & 7)) << 4)), vst = (unsigned)(8192 + srow * 128 + ((sch ^ (((srow >> 1) & 1) << 2)) << 4));
    for (int ui = C.vcu; ui < 1024; ui += C.G) {
        const int v = ui & 255, n = ui >> 8, k16 = v & 15;
        const int bg = (n < 2 ? 0 : 16) + (v >> 4), qt = n == 0 ? k16 : (n == 1 ? 31 - k16 : (n == 2 ? 15 - k16 : 16 + k16));
        const int b = bg >> 2, g = bg & 3, h = 4 * g + r4, t = 64 * qt + tok, row = b * S + t;
        bf16x8 qf[4];
#pragma unroll
        for (int ks = 0; ks < 4; ++ks) qf[ks] = *(const bf16x8*)(Q + (size_t)row * 1024 + h * 64 + 16 * ks + 8 * hh);
        const LAS float* lutp = lut2 + h * 129; const float lut128 = lutp[128];
        const bf16* KCb = KC + (size_t)bg * 128 * 64; const bf16* VCb = VC + (size_t)bg * 128 * 64;
        const bf16* KSb = KV + 2 * TS + (size_t)bg * 2048 * 64; const bf16* VSb = KV + 3 * TS + (size_t)bg * 2048 * 64;
        const bf16* KWb = KV + 4 * TS + (size_t)bg * 2048 * 64; const bf16* VWb = KV + 5 * TS + (size_t)bg * 2048 * 64;
        const int nslc = qt + 1, nwin = qt + 1 < 9 ? qt + 1 : 9, wlo = qt + 1 - nwin, ntile = 2 + nslc + nwin;
        const bool need_sel = qt >= 16;
        unsigned mysel = 0xffffffffu;
        Soft st; st.m = -1e30f; st.l = 0.f;
        f32x16 y0, y1;
#pragma unroll
        for (int i = 0; i < 16; ++i) { st.o0[i] = 0.f; st.o1[i] = 0.f; y0[i] = 0.f; y1[i] = 0.f; }
        v4u kreg = ((const v4u*)KCb)[tid], vreg = ((const v4u*)VCb)[tid];
        *(LAS v4u*)(L + kst) = kreg; *(LAS v4u*)(L + vst) = vreg;
        __syncthreads();
        float alpha1 = 1.f;
        for (int i = 0; i < ntile; ++i) {
            const int cb = (i & 1) * 16384, nb = ((i + 1) & 1) * 16384; const bool more = i + 1 < ntile;
            if (more) { const int i1 = i + 1; const bf16* kp; const bf16* vp;
                if (i1 < 2) { kp = KCb + 4096; vp = VCb + 4096; }
                else if (i1 < 2 + nslc) { kp = KSb + (size_t)(i1 - 2) * 4096; vp = VSb + (size_t)(i1 - 2) * 4096; }
                else { const int j = wlo + (i1 - 2 - nslc); kp = KWb + (size_t)j * 4096; vp = VWb + (size_t)j * 4096; }
                kreg = ((const v4u*)kp)[tid]; vreg = ((const v4u*)vp)[tid]; }
            int kind, base_d; bool sel = true; LAS float* ge = nullptr; int gj0 = 0;
            if (i < 2) { kind = 0; base_d = t - 31 - 1024 * i - 64 * hh; if (need_sel) { ge = GE + (r4 * 64 + tok) * 32; gj0 = 16 * i + hh; } }
            else if (i < 2 + nslc) { const int j = i - 2; sel = ((mysel >> j) & 1u) != 0u; base_d = 64 * (qt - j) + tok - 4 * hh; kind = (qt - j <= 2) ? 1 : 2; }
            else { const int j = wlo + (i - 2 - nslc); base_d = 64 * (qt - j) + tok - 4 * hh; kind = (qt - j <= 2) ? 1 : ((qt - j == 8) ? 3 : 2); }
            float al;
            attn_tile(st, L + cb, L + cb + 8192, qf, kof, vof0, vof1, kind, base_d, sel, lutp, lut128, ge, gj0, al);
            if (i == 1) alpha1 = al;
            const bool endb = (i == 1) || (i == 1 + nslc) || (i == ntile - 1);
            if (endb) {
                const int br = i == 1 ? 0 : (i == 1 + nslc ? 1 : 2);
                const float lf = xhalf_sum(st.l), inv = lf > 0.f ? 1.0f / lf : 0.f;
                if (br == 0 && need_sel && hh == 0) { SCp[(r4 * 64 + tok) * 2] = alpha1 * inv; SCp[(r4 * 64 + tok) * 2 + 1] = inv; }
                const float coef = GT[(size_t)row * 48 + br * 16 + h] * inv;
                const bf16* zp = Z + (size_t)row * 3072 + br * 1024 + h * 64 + 4 * hh;
#pragma unroll
                for (int i4 = 0; i4 < 4; ++i4) {
                    const uint2 za = *(const uint2*)(zp + 8 * i4), zb = *(const uint2*)(zp + 32 + 8 * i4);
                    y0[4 * i4] += st.o0[4 * i4] * coef * bflo(za.x); y0[4 * i4 + 1] += st.o0[4 * i4 + 1] * coef * bfhi(za.x);
                    y0[4 * i4 + 2] += st.o0[4 * i4 + 2] * coef * bflo(za.y); y0[4 * i4 + 3] += st.o0[4 * i4 + 3] * coef * bfhi(za.y);
                    y1[4 * i4] += st.o1[4 * i4] * coef * bflo(zb.x); y1[4 * i4 + 1] += st.o1[4 * i4 + 1] * coef * bfhi(zb.x);
                    y1[4 * i4 + 2] += st.o1[4 * i4 + 2] * coef * bflo(zb.y); y1[4 * i4 + 3] += st.o1[4 * i4 + 3] * coef * bfhi(zb.y); }
                st.m = -1e30f; st.l = 0.f;
#pragma unroll
                for (int q = 0; q < 16; ++q) { st.o0[q] = 0.f; st.o1[q] = 0.f; }
            }
            if (more) { *(LAS v4u*)(L + nb + kst) = kreg; *(LAS v4u*)(L + nb + vst) = vreg; }
            __syncthreads();
            if (i == 1 && need_sel) {
                const LAS float* Gp = GE; const LAS float* Ep = GE + 8192;
#pragma unroll 1
                for (int k = 0; k < 4; ++k) {
                    const int tk = (tid >> 5) + 16 * k, j = tid & 31; float imp = 0.f;
#pragma unroll
                    for (int r = 0; r < 4; ++r) { const int ro = r * 64 + tk; const float f0 = SCp[ro * 2], f1 = SCp[ro * 2 + 1];
                        imp += Gp[ro * 32 + j] * (j < 16 ? f0 : f1);
                        if (j > 0) imp += Ep[ro * 32 + j - 1] * (j - 1 < 16 ? f0 : f1); }
                    const bool valid = j <= qt, forced = (j == 0) || (j == qt) || (j == qt - 1);
                    const float score = valid ? imp + (forced ? 1000.0f : 0.f) : -1e30f;
                    int rank = 0;
                    for (int i2 = 0; i2 < 32; ++i2) { const float si = __shfl(score, (lane & 32) | i2); rank += ((si > score) || (si == score && i2 < j)) ? 1 : 0; }
                    const unsigned long long bal = __ballot(rank < 16);
                    if ((lane & 31) == 0) SELM[tk] = (unsigned)(lane < 32 ? bal : (bal >> 32));
                }
                __syncthreads();
                mysel = SELM[tok];
            }
        }
        bf16* yp = Q + (size_t)row * 1024 + h * 64 + 4 * hh;
#pragma unroll
        for (int i4 = 0; i4 < 4; ++i4) {
            uint2 a, bb; a.x = cvtpk(y0[4 * i4], y0[4 * i4 + 1]); a.y = cvtpk(y0[4 * i4 + 2], y0[4 * i4 + 3]); bb.x = cvtpk(y1[4 * i4], y1[4 * i4 + 1]); bb.y = cvtpk(y1[4 * i4 + 2], y1[4 * i4 + 3]);
            *(uint2*)(yp + 8 * i4) = a; *(uint2*)(yp + 32 + 8 * i4) = bb; }
    }
}
}
constexpr int PH_PER_PAIR = 9, N_PHASES = 1 + 2 * PH_PER_PAIR;
struct Args { const float* in[15]; float* out; unsigned char* ws; int ph_lo, ph_hi; };
#define IN(k) (lo <= (k) && (k) < hi)
#define SEAM(k) do { if (IN(k) && IN((k) + 1)) xcd_barrier(bar); } while (0)
template <int p> __device__ __forceinline__ void layer_pair(const Ctx& C, const XcdBarrier& bar, const int lo, const int hi) {
    unsigned char* ws = C.ws;
    float* rss_base = (float*)(ws + WS_CTL) + CW_RSS;
    bf16* WIN = (bf16*)(ws + WS_WIN); bf16* WOUT = (bf16*)(ws + WS_WOUT); bf16* HB = (bf16*)(ws + WS_HB);
        const int pb = 1 + PH_PER_PAIR * p, L0 = 2 * p, L1 = 2 * p + 1;
        if (IN(pb + 0)) {
            pg8::Gemm g{HB, WIN, M, NSA_NP, 1024}; pg8::StaticOrder So; So.init(M, NSA_NP, C.G, (int)blockIdx.x);
            pg8::EpiNsaProj E{rss_base + (size_t)L0 * 16384, (bf16*)(ws + NSA_Q), (bf16*)(ws + NSA_KV), (bf16*)(ws + NSA_Z), (float*)(ws + NSA_GT)};
            pg8::gemm_phase<pg8::EpiNsaProj, pg8::StaticOrder, true, true>(C.lds + RING_OFF, g, So, E);
        }
        SEAM(pb + 0);
        if (IN(pb + 1)) {
            convert_weights<0>(C, C.in[IN_NWOUT] + (size_t)p * 1024 * 1024, 1024, 1024, 1024, nullptr, WOUT);
            convert_weights<0>(C, C.in[IN_RWIN] + (size_t)p * 1024 * 6144, 1024, 6144, RET_NP, C.in[IN_PRE] + (size_t)L1 * D, WIN);
            __syncthreads();
            naive_compress(C, p);
        }
        SEAM(pb + 1);
        if (IN(pb + 2)) nsa::nsa_attn_phase(C);
        SEAM(pb + 2);
        if (IN(pb + 3)) {
            pg8::Gemm g{(const bf16*)(ws + NSA_Q), WOUT, M, 1024, 1024}; pg8::StaticOrder So; So.init(M, 1024, C.G, (int)blockIdx.x);
            pg8::EpiF32 E{(float*)(ws + NSA_YO), 1024};
            pg8::gemm_phase<pg8::EpiF32, pg8::StaticOrder, true, true>(C.lds + RING_OFF, g, So, E);
        }
        SEAM(pb + 3);
        if (IN(pb + 4)) naive_norm_res(C, L0, (const float*)(ws + NSA_YO));
        SEAM(pb + 4);
        if (IN(pb + 5)) {
            pg8::Gemm g{HB, WIN, M, RET_NP, 1024}; pg8::StaticOrder So; So.init(M, RET_NP, C.G, (int)blockIdx.x);
            pg8::EpiRetProj E{rss_base + (size_t)L1 * 16384, (const float*)(ws + WS_COS), (const float*)(ws + WS_SIN), (bf16*)(ws + RET_Q), (bf16*)(ws + RET_K), (bf16*)(ws + RET_V), (bf16*)(ws + RET_Z)};
            pg8::gemm_phase<pg8::EpiRetProj, pg8::StaticOrder, true, true>(C.lds + RING_OFF, g, So, E);
        }
        SEAM(pb + 5);
        if (IN(pb + 6)) {
            convert_weights<0>(C, C.in[IN_RWOUT] + (size_t)p * 2048 * 1024, 2048, 1024, 1024, nullptr, WOUT);
            if (p == 0) convert_weights<1>(C, C.in[IN_NWIN] + (size_t)1 * 1024 * 5680, 1024, 5680, NSA_NP, C.in[IN_PRE] + (size_t)2 * D, WIN);
            __syncthreads();
            naive_retention(C, p);
        }
        SEAM(pb + 6);
        if (IN(pb + 7)) {
            pg8::Gemm g{(const bf16*)(ws + RET_Z), WOUT, M, 1024, 2048}; pg8::StaticOrder So; So.init(M, 1024, C.G, (int)blockIdx.x);
            pg8::EpiF32 E{(float*)(ws + RET_YO), 1024};
            pg8::gemm_phase<pg8::EpiF32, pg8::StaticOrder, true, true>(C.lds + RING_OFF, g, So, E);
        }
        SEAM(pb + 7);
        if (IN(pb + 8)) naive_norm_res(C, L1, (const float*)(ws + RET_YO));
        SEAM(pb + 8);
    }
__global__ void __launch_bounds__(NTHR, 2) hybrid_fwd(Args args) {
    extern __shared__ __attribute__((aligned(16))) unsigned char lds[];
    Ctx C;
    C.lds = (LAS unsigned char*)lds;
    C.tid = threadIdx.x; C.lane = C.tid & 63; C.wave = __builtin_amdgcn_readfirstlane(C.tid >> 6);
    C.G = gridDim.x; { const int bx = blockIdx.x; C.vcu = (C.G % 8 == 0) ? (bx % 8) * (C.G / 8) + bx / 8 : bx; }
#pragma unroll
    for (int i = 0; i < 15; ++i) C.in[i] = args.in[i];
    C.out = args.out; C.ws = args.ws;
    unsigned char* ws = args.ws;
    gu32* ctl = (gu32*)(ws + WS_CTL);
    volatile LAS unsigned* MISC = (volatile LAS unsigned*)(C.lds + MISC_OFF);
    for (int u = C.tid; u < (LDS_BYTES - LDSCTL_OFF) / 4; u += NTHR) ((LAS unsigned*)(C.lds + LDSCTL_OFF))[u] = 0u;
    __syncthreads();
    XcdBarrier bar = xcd_barrier_post((unsigned*)(ctl + CW_BAR), MISC + 8);
    const int lo = args.ph_lo, hi = args.ph_hi;
    float* rss_base = (float*)(ws + WS_CTL) + CW_RSS;
    bf16* WIN = (bf16*)(ws + WS_WIN); bf16* WOUT = (bf16*)(ws + WS_WOUT); bf16* HB = (bf16*)(ws + WS_HB);

    if (IN(0)) {
        convert_weights<1>(C, C.in[IN_NWIN], 1024, 5680, NSA_NP, C.in[IN_PRE], WIN);
        p0_rows(C); p0_tables(C);
    }
    SEAM(0);
    layer_pair<0>(C, bar, lo, hi);
    layer_pair<1>(C, bar, lo, hi);
#undef IN
#undef SEAM
}

#ifndef N_LAUNCH_MODE
#define N_LAUNCH_MODE 1
#endif
extern "C" void kernel_launch(void* const* d_in, const int* in_sizes, int n_in, void* d_out, int out_size, void* d_ws, size_t ws_size, hipStream_t stream) {
    static int grid = 0;
    if (grid == 0) {
        if (n_in != 15 || out_size != M * D || ws_size < WS_END) { fprintf(stderr, "kernel_launch: unexpected problem shape (n_in %d, out %d, ws %zu)\n", n_in, out_size, ws_size); grid = -1; return; }
        int dev = 0, cus = 0, per_cu = 0;
        if (hipGetDevice(&dev) != hipSuccess || hipDeviceGetAttribute(&cus, hipDeviceAttributeMultiprocessorCount, dev) != hipSuccess) { grid = -1; return; }
        if (hipFuncSetAttribute((const void*)hybrid_fwd, hipFuncAttributeMaxDynamicSharedMemorySize, LDS_BYTES) != hipSuccess) { fprintf(stderr, "kernel_launch: hipFuncSetAttribute failed\n"); grid = -1; return; }
        if (hipOccupancyMaxActiveBlocksPerMultiprocessor(&per_cu, (const void*)hybrid_fwd, NTHR, LDS_BYTES) != hipSuccess || per_cu < 1) { fprintf(stderr, "kernel_launch: occupancy query reports %d blocks per CU\n", per_cu); }
        (void)hipGetLastError();
        grid = cus;
    }
    if (grid < 0) return;
    if (hipMemsetAsync((char*)d_ws + WS_CTL, 0, CTL_ZERO_BYTES, stream) != hipSuccess) return;
    Args a{};
    for (int i = 0; i < 15; ++i) a.in[i] = (const float*)d_in[i];
    a.out = (float*)d_out; a.ws = (unsigned char*)d_ws;
#if N_LAUNCH_MODE == 1
    a.ph_lo = 0; a.ph_hi = N_PHASES;
    hipLaunchKernelGGL(hybrid_fwd, dim3(grid), dim3(NTHR), LDS_BYTES, stream, a);
#else
    for (int k = 0; k < N_PHASES; ++k) { a.ph_lo = k; a.ph_hi = k + 1; hipLaunchKernelGGL(hybrid_fwd, dim3(grid), dim3(NTHR), LDS_BYTES, stream, a); }
#endif
}
```

```cpp
#include <hip/hip_runtime.h>
#include <cstdio>
#include <cstdint>
namespace pg8 {
#define PG8_LAS __attribute__((address_space(3)))
typedef unsigned short bf16_t;
typedef short bf16x8 __attribute__((ext_vector_type(8)));
typedef float f32x4 __attribute__((ext_vector_type(4)));
typedef unsigned u32x4 __attribute__((ext_vector_type(4)));
constexpr int BM = 256, BK = 64, HALF = 128, HTB = HALF * BK * 2  , STAGE_BYTES = 8 * HTB, NXCD = 8, WGM = 8;

__host__ __device__ __forceinline__ int lds_byte(int r, int c) { const int st = (r >> 4) * 2 + (c >> 5), rr = r & 15, cc = c & 31, ob = rr * 64 + cc * 2; return st * 1024 + (ob ^ (((ob >> 9) & 1) << 5)); }
__host__ __device__ __forceinline__ void stage_rc(int b, int& R, int& C) { const int st = b / 1024, sb = b % 1024, swz = sb ^ (((sb >> 9) & 1) << 5); R = (st >> 1) * 16 + swz / 64; C = (st & 1) * 32 + (swz % 64) / 2; }
__host__ __device__ __forceinline__ int perm32(int rho) { const int n = rho >> 4, i = rho & 15; return 8 * (i >> 2) + 4 * n + (i & 3); }

struct Unit { int pm, pn; };
struct Gemm { const bf16_t* A; const bf16_t* Bt; int M, N, K; };

struct StaticOrder {
    int nM, nN, nwg, G, c;
    __host__ __device__ void init(int M, int N, int G_, int c_) { nM = M / BM; nN = N / BM; nwg = nM * nN; G = G_; c = c_; }
    __host__ __device__ bool next(int i, Unit& u) const {
        const long L = (long)i * G + c; if (L >= nwg) return false;
        int wgid = (int)L; { const int q = nwg / NXCD, r = nwg % NXCD, xcd = wgid % NXCD, off = wgid / NXCD; wgid = (xcd < r ? xcd * (q + 1) : r * (q + 1) + (xcd - r) * q) + off; }
        const int nig = WGM * nN, gid = wgid / nig, fm = gid * WGM, gsz = (nM - fm) < WGM ? (nM - fm) : WGM;
        u.pm = fm + ((wgid % nig) % gsz); u.pn = (wgid % nig) / gsz; return true;
    }
    __device__ __forceinline__ void a_ready(const Unit&) const {}
    __device__ __forceinline__ void done(const Unit&) const {}
};

__device__ __forceinline__ unsigned cvt_pk_bf16(float lo, float hi) { unsigned r; asm volatile("v_cvt_pk_bf16_f32 %0, %1, %2" : "=v"(r) : "v"(lo), "v"(hi)); return r; }
typedef float f32x2 __attribute__((ext_vector_type(2)));
__device__ __forceinline__ float silu_f(float x) { return x / (1.0f + __expf(-x)); }
__device__ __forceinline__ float sigm_f(float x) { return 1.0f / (1.0f + __expf(-x)); }
__device__ __forceinline__ u32x4 pack8(const f32x4 a, const f32x4 b) { u32x4 w; w.x = cvt_pk_bf16(a[0], a[1]); w.y = cvt_pk_bf16(a[2], a[3]); w.z = cvt_pk_bf16(b[0], b[1]); w.w = cvt_pk_bf16(b[2], b[3]); return w; }
struct EpiNsaProj {
    static constexpr bool PERM = true, AFTER_DRAIN = false;
    const float* rss; bf16_t* Q; bf16_t* KV; bf16_t* Z; float* GT;
    __device__ __forceinline__ void operator()(const f32x4 (&acc)[2][2][4][2], const Unit& u, int wr, int wc, int fr, int fq) const {
        const int row0 = u.pm * BM + wr * 64 + fr, cl = wc * 32 + 8 * fq, pn = u.pn;
#pragma unroll
        for (int ai = 0; ai < 2; ++ai)
#pragma unroll
            for (int m = 0; m < 4; ++m) {
                const int row = row0 + ai * HALF + m * 16;
                const float rs = rsqrtf(rss[row] * (1.0f / 1024.0f) + 1e-6f);
#pragma unroll
                for (int bj = 0; bj < 2; ++bj) {
                    const int c = bj * HALF + cl;
                    f32x4 v0 = acc[ai][bj][m][0] * rs, v1 = acc[ai][bj][m][1] * rs;
                    if (pn < 4) { *(u32x4*)(Q + (size_t)row * 1024 + pn * 256 + c) = pack8(v0, v1); }
                    else if (pn < 10) { const int j = pn - 4, g = c >> 6, d = c & 63, b = row >> 11, s = row & 2047;
                        *(u32x4*)(KV + (size_t)j * (16384 * 256) + ((size_t)((b * 4 + g) * 2048 + s)) * 64 + d) = pack8(v0, v1); }
                    else if (pn < 22) {
#pragma unroll
                        for (int e = 0; e < 4; ++e) { v0[e] = silu_f(v0[e]); v1[e] = silu_f(v1[e]); }
                        *(u32x4*)(Z + (size_t)row * 3072 + (pn - 10) * 256 + c) = pack8(v0, v1); }
                    else if (c < 48) {
#pragma unroll
                        for (int e = 0; e < 4; ++e) { v0[e] = sigm_f(v0[e]); v1[e] = sigm_f(v1[e]); }
                        *(f32x4*)(GT + (size_t)row * 48 + c) = v0; *(f32x4*)(GT + (size_t)row * 48 + c + 4) = v1; }
                }
            }
    }
};
struct EpiRetProj {
    static constexpr bool PERM = true, AFTER_DRAIN = false;
    const float* rss; const float* COS; const float* SIN; bf16_t* Q; bf16_t* K; bf16_t* V; bf16_t* Z;
    __device__ __forceinline__ void operator()(const f32x4 (&acc)[2][2][4][2], const Unit& u, int wr, int wc, int fr, int fq) const {
        const int row0 = u.pm * BM + wr * 64 + fr, cl = wc * 32 + 8 * fq, pn = u.pn;
#pragma unroll
        for (int ai = 0; ai < 2; ++ai)
#pragma unroll
            for (int m = 0; m < 4; ++m) {
                const int row = row0 + ai * HALF + m * 16;
                const float rs = rsqrtf(rss[row] * (1.0f / 1024.0f) + 1e-6f);
                if (pn < 8) {
                    const float sc = pn < 4 ? rs : rs * 0.0625f;
                    const int s = row & 2047;
                    const f32x4 c0 = *(const f32x4*)(COS + s * 128 + cl), c1 = *(const f32x4*)(COS + s * 128 + cl + 4);
                    const f32x4 s0 = *(const f32x4*)(SIN + s * 128 + cl), s1 = *(const f32x4*)(SIN + s * 128 + cl + 4);
                    const f32x4 a0 = acc[ai][0][m][0] * sc, a1 = acc[ai][0][m][1] * sc, b0 = acc[ai][1][m][0] * sc, b1 = acc[ai][1][m][1] * sc;
                    const f32x4 o10 = a0 * c0 - b0 * s0, o11 = a1 * c1 - b1 * s1, o20 = a0 * s0 + b0 * c0, o21 = a1 * s1 + b1 * c1;
                    bf16_t* base = (pn < 4 ? Q : K) + (size_t)row * 1024 + (pn & 3) * 256 + cl;
                    *(u32x4*)(base) = pack8(o10, o11); *(u32x4*)(base + 128) = pack8(o20, o21);
                } else {
#pragma unroll
                    for (int bj = 0; bj < 2; ++bj) {
                        const int c = bj * HALF + cl;
                        f32x4 v0 = acc[ai][bj][m][0] * rs, v1 = acc[ai][bj][m][1] * rs;
                        if (pn < 16) { *(u32x4*)(V + (size_t)row * 2048 + (pn - 8) * 256 + c) = pack8(v0, v1); }
                        else {
#pragma unroll
                            for (int e = 0; e < 4; ++e) { v0[e] = silu_f(v0[e]); v1[e] = silu_f(v1[e]); }
                            *(u32x4*)(Z + (size_t)row * 2048 + (pn - 16) * 256 + c) = pack8(v0, v1); }
                    }
                }
            }
    }
};
struct EpiF32 {
    static constexpr bool PERM = true, AFTER_DRAIN = false;
    float* O; int ldc;
    __device__ __forceinline__ void operator()(const f32x4 (&acc)[2][2][4][2], const Unit& u, int wr, int wc, int fr, int fq) const {
        const int row0 = u.pm * BM + wr * 64 + fr, cl = u.pn * BM + wc * 32 + 8 * fq;
#pragma unroll
        for (int ai = 0; ai < 2; ++ai)
#pragma unroll
            for (int m = 0; m < 4; ++m)
#pragma unroll
                for (int bj = 0; bj < 2; ++bj) { float* p = O + (size_t)(row0 + ai * HALF + m * 16) * ldc + cl + bj * HALF;
                    *(f32x4*)p = acc[ai][bj][m][0]; *(f32x4*)(p + 4) = acc[ai][bj][m][1]; }
    }
};

template <class Epi, class Sched, bool ALIGN_EPI = false, bool SP2 = false>
__device__ __forceinline__ void gemm_phase(PG8_LAS unsigned char* lds, const Gemm g, const Sched& S, const Epi& E) {
    const int tid = threadIdx.x, wid = __builtin_amdgcn_readfirstlane(tid >> 6), lane = tid & 63, wr = wid >> 2, wc = wid & 3, fr = lane & 15, fq = lane >> 4;
    const int K = g.K, nt = K / BK;
    unsigned voffA[2], voffB[2];
#pragma unroll
    for (int i = 0; i < 2; ++i) { int R, C; stage_rc(tid * 16 + i * 8192, R, C); const int Rb = Epi::PERM ? ((R & ~31) + perm32(R & 31)) : R;
        voffA[i] = (unsigned)(R * K + C) * 2u; voffB[i] = (unsigned)(Rb * K + C) * 2u; }
    const size_t kstep = (size_t)(BK * 2);
    const size_t hstep = (size_t)HALF * K * 2;
    const size_t tstep = 2 * hstep;
    const unsigned ldsw = (unsigned)wid * 1024u;
    const int aoff = lds_byte(wr * 64 + fr, fq * 8), boff = lds_byte(wc * 32 + fr, fq * 8);
#define PG8_SA(b, h) (((b) * 2 + (h)) * HTB)
#define PG8_SB(b, h) ((4 + (b) * 2 + (h)) * HTB)
#define PG8_STAGE(bufoff, gbase, voff) do { _Pragma("unroll") for (int _i = 0; _i < 2; ++_i) \
        __builtin_amdgcn_global_load_lds((const unsigned*)((const char*)(gbase) + (voff)[_i]), (PG8_LAS unsigned*)(lds + (bufoff) + ldsw + _i * 8192), 16, 0, 0); } while (0)
#define PG8_LDA(dst, b, h) do { _Pragma("unroll") for (int m = 0; m < 4; ++m) _Pragma("unroll") for (int k = 0; k < 2; ++k) dst[m][k] = *(const PG8_LAS bf16x8*)(lds + PG8_SA(b, h) + aoff + m * 2048 + k * 1024); } while (0)
#define PG8_LDB(dst, b, h) do { _Pragma("unroll") for (int n = 0; n < 2; ++n) _Pragma("unroll") for (int k = 0; k < 2; ++k) dst[n][k] = *(const PG8_LAS bf16x8*)(lds + PG8_SB(b, h) + boff + n * 2048 + k * 1024); } while (0)
#define PG8_MMA(ai, bj, At, Bt) do { __builtin_amdgcn_s_setprio(1); _Pragma("unroll") for (int m = 0; m < 4; ++m) _Pragma("unroll") for (int n = 0; n < 2; ++n) _Pragma("unroll") for (int k = 0; k < 2; ++k) \
        acc[ai][bj][m][n] = __builtin_amdgcn_mfma_f32_16x16x32_bf16(Bt[n][k], At[m][k], acc[ai][bj][m][n], 0, 0, 0); __builtin_amdgcn_s_setprio(0); } while (0)
#define PG8_WAIT_V(n) asm volatile("s_waitcnt vmcnt(" #n ")" ::: "memory")
#define PG8_WAIT_L(n) asm volatile("s_waitcnt lgkmcnt(" #n ")" ::: "memory")
#define PG8_BAR __builtin_amdgcn_s_barrier()
#define PG8_SCHED __builtin_amdgcn_sched_barrier(0)
    Unit cur, nxt; int ui = 0;
    if (!S.next(0, cur)) return;
    f32x4 acc[2][2][4][2];
#pragma unroll
    for (int a = 0; a < 2; ++a)
#pragma unroll
        for (int b = 0; b < 2; ++b)
#pragma unroll
            for (int m = 0; m < 4; ++m)
#pragma unroll
                for (int n = 0; n < 2; ++n) acc[a][b][m][n] = (f32x4){0.f, 0.f, 0.f, 0.f};
    bf16x8 At[4][2], B0[2][2], B1[2][2];
    const char* cA = (const char*)g.A + (size_t)cur.pm * tstep; const char* cB = (const char*)g.Bt + (size_t)cur.pn * tstep;
    S.a_ready(cur);
    if constexpr (SP2) {
        PG8_STAGE(PG8_SB(0, 0), cB, voffB); PG8_STAGE(PG8_SB(0, 1), cB + hstep, voffB); PG8_STAGE(PG8_SA(0, 0), cA, voffA); PG8_STAGE(PG8_SA(0, 1), cA + hstep, voffA);
        if (wr == 1) PG8_BAR;
        PG8_WAIT_V(2); PG8_BAR;
        PG8_STAGE(PG8_SB(1, 0), cB + kstep, voffB); PG8_STAGE(PG8_SA(1, 0), cA + kstep, voffA); PG8_STAGE(PG8_SB(1, 1), cB + hstep + kstep, voffB);
        PG8_WAIT_V(6); PG8_BAR;
    } else {
        PG8_STAGE(PG8_SB(0, 0), cB, voffB); PG8_STAGE(PG8_SA(0, 0), cA, voffA); PG8_STAGE(PG8_SB(0, 1), cB + hstep, voffB); PG8_STAGE(PG8_SA(0, 1), cA + hstep, voffA);
        if (wr == 1) PG8_BAR;
        PG8_WAIT_V(4); PG8_BAR;
        PG8_STAGE(PG8_SB(1, 0), cB + kstep, voffB); PG8_STAGE(PG8_SA(1, 0), cA + kstep, voffA); PG8_STAGE(PG8_SB(1, 1), cB + hstep + kstep, voffB);
        PG8_WAIT_V(6); PG8_BAR;
    }
    for (;;) {
        const bool has_next = S.next(ui + 1, nxt);
        const char* nA = has_next ? (const char*)g.A + (size_t)nxt.pm * tstep : cA; const char* nB = has_next ? (const char*)g.Bt + (size_t)nxt.pn * tstep : cB;
        for (int t = 0; t < nt; t += 2) {
            const bool last = (t == nt - 2);
            const char* a1 = cA + (size_t)(t + 1) * kstep;
            const char* a2 = last ? nA : cA + (size_t)(t + 2) * kstep; const char* b2 = last ? nB : cB + (size_t)(t + 2) * kstep;
            const char* a3 = a2 + kstep; const char* b3 = b2 + kstep;
            if (last && has_next) S.a_ready(nxt);
            if constexpr (SP2) {
            PG8_LDB(B0, 0, 0); PG8_LDB(B1, 0, 1); PG8_SCHED; PG8_LDA(At, 0, 0); PG8_STAGE(PG8_SA(1, 1), a1 + hstep, voffA);
            PG8_WAIT_V(8); PG8_WAIT_L(0); PG8_BAR; PG8_MMA(0, 0, At, B0); PG8_MMA(0, 1, At, B1); PG8_BAR; PG8_SCHED;
            PG8_LDA(At, 0, 1); PG8_STAGE(PG8_SB(0, 0), b2, voffB); PG8_STAGE(PG8_SB(0, 1), b2 + hstep, voffB); PG8_STAGE(PG8_SA(0, 0), a2, voffA);
            PG8_WAIT_V(8); PG8_WAIT_L(0); PG8_BAR; PG8_MMA(1, 0, At, B0); PG8_MMA(1, 1, At, B1); PG8_BAR; PG8_SCHED;
            PG8_LDB(B0, 1, 0); PG8_LDB(B1, 1, 1); PG8_SCHED; PG8_LDA(At, 1, 0); PG8_STAGE(PG8_SA(0, 1), a2 + hstep, voffA);
            PG8_WAIT_V(8); PG8_WAIT_L(0); PG8_BAR; PG8_MMA(0, 0, At, B0); PG8_MMA(0, 1, At, B1); PG8_BAR; PG8_SCHED;
            PG8_LDA(At, 1, 1); PG8_STAGE(PG8_SB(1, 0), b3, voffB); PG8_STAGE(PG8_SB(1, 1), b3 + hstep, voffB); PG8_STAGE(PG8_SA(1, 0), a3, voffA);
            PG8_WAIT_V(8); PG8_WAIT_L(0); PG8_BAR; PG8_MMA(1, 0, At, B0); PG8_MMA(1, 1, At, B1); PG8_BAR; PG8_SCHED;
            } else {
            PG8_LDB(B0, 0, 0); PG8_SCHED; PG8_LDA(At, 0, 0); PG8_STAGE(PG8_SA(1, 1), a1 + hstep, voffA);
            PG8_WAIT_L(8); PG8_BAR; PG8_WAIT_L(0); PG8_MMA(0, 0, At, B0); PG8_BAR; PG8_SCHED;
            PG8_LDB(B1, 0, 1); PG8_STAGE(PG8_SB(0, 0), b2, voffB);
            PG8_BAR; PG8_WAIT_L(0); PG8_MMA(0, 1, At, B1); PG8_BAR;
            PG8_LDA(At, 0, 1); PG8_STAGE(PG8_SA(0, 0), a2, voffA);
            PG8_BAR; PG8_WAIT_L(0); PG8_MMA(1, 0, At, B0); PG8_BAR; PG8_SCHED;
            PG8_STAGE(PG8_SB(0, 1), b2 + hstep, voffB);
            PG8_WAIT_V(6); PG8_BAR; PG8_MMA(1, 1, At, B1); PG8_BAR;
            PG8_LDB(B0, 1, 0); PG8_SCHED; PG8_LDA(At, 1, 0); PG8_STAGE(PG8_SA(0, 1), a2 + hstep, voffA);
            PG8_WAIT_L(8); PG8_BAR; PG8_WAIT_L(0); PG8_MMA(0, 0, At, B0); PG8_BAR; PG8_SCHED;
            PG8_LDB(B1, 1, 1); PG8_STAGE(PG8_SB(1, 0), b3, voffB);
            PG8_BAR; PG8_WAIT_L(0); PG8_MMA(0, 1, At, B1); PG8_BAR;
            PG8_LDA(At, 1, 1); PG8_STAGE(PG8_SA(1, 0), a3, voffA);
            PG8_BAR; PG8_WAIT_L(0); PG8_MMA(1, 0, At, B0); PG8_BAR; PG8_SCHED;
            PG8_STAGE(PG8_SB(1, 1), b3 + hstep, voffB);
            PG8_WAIT_V(6); PG8_BAR; PG8_MMA(1, 1, At, B1); PG8_BAR;
            }
        }
        if constexpr (ALIGN_EPI) { if (wr == 0) PG8_BAR; }
        if constexpr (!Epi::AFTER_DRAIN) { E(acc, cur, wr, wc, fr, fq); S.done(cur); }
        if (!has_next) break;
#pragma unroll
        for (int a = 0; a < 2; ++a)
#pragma unroll
            for (int b = 0; b < 2; ++b)
#pragma unroll
                for (int m = 0; m < 4; ++m)
#pragma unroll
                    for (int n = 0; n < 2; ++n) acc[a][b][m][n] = (f32x4){0.f, 0.f, 0.f, 0.f};
        cur = nxt; cA = nA; cB = nB; ++ui;
        if constexpr (ALIGN_EPI) { if (wr == 1) PG8_BAR; }
    }
    PG8_WAIT_V(0);
    if constexpr (!ALIGN_EPI) { if (wr == 0) PG8_BAR; }
    PG8_BAR;
    if constexpr (Epi::AFTER_DRAIN) { E.fused(acc, cur, wr, wc, fr, fq, lds, wid, lane); S.done(cur); }
#undef PG8_SA
#undef PG8_SB
#undef PG8_STAGE
#undef PG8_LDA
#undef PG8_LDB
#undef PG8_MMA
#undef PG8_WAIT_V
#undef PG8_WAIT_L
#undef PG8_BAR
#undef PG8_SCHED
}
}
constexpr int NWAVES = 8, NTHR = 512;
constexpr int BATCH = 8, S = 2048, D = 1024, M = BATCH * S;
constexpr int NSA_NP = 5888, RET_NP = 6144;
constexpr int NCMP = 127;
constexpr float RMS_EPS = 1e-6f, GN_EPS = 1e-6f;
constexpr size_t MiB = 1u << 20;
constexpr size_t WS_CTL = 0, CTL_ZERO_BYTES = 1 * MiB;
constexpr size_t WS_COS = 1 * MiB, WS_SIN = 2 * MiB;
constexpr size_t WS_WIN = 4 * MiB;
constexpr size_t WS_WOUT = 16 * MiB;
constexpr size_t WS_HB = 24 * MiB;
constexpr size_t WS_ACT = 56 * MiB;
constexpr size_t NSA_Q = WS_ACT, NSA_KV = WS_ACT + 32 * MiB, NSA_Z = WS_ACT + 80 * MiB, NSA_GT = WS_ACT + 176 * MiB, NSA_KC = WS_ACT + 179 * MiB, NSA_VC = WS_ACT + 180 * MiB;
constexpr size_t NSA_YO = NSA_Z;
constexpr size_t RET_Q = WS_ACT, RET_K = WS_ACT + 32 * MiB, RET_V = WS_ACT + 64 * MiB, RET_Z = WS_ACT + 128 * MiB;
constexpr size_t RET_YO = RET_Q;
constexpr size_t WS_END = WS_ACT + 192 * MiB;
static_assert(WS_END <= 256 * MiB, "d_ws map");
constexpr int CW_TMO = 0, CW_CODE = 1;
constexpr int CW_BAR = 4096;
constexpr int CW_RSS = 16384;
static_assert((CW_RSS + 5 * 16384) * 4 <= (int)CTL_ZERO_BYTES, "CTL words inside the memset region");
constexpr int RING_OFF = 0, RING_BYTES = 139264;
constexpr int LDSCTL_OFF = RING_BYTES, MISC_OFF = LDSCTL_OFF + 320;
constexpr int LDS_BYTES = 147456;
#define GAS __attribute__((address_space(1)))
#define LAS __attribute__((address_space(3)))
typedef unsigned short bf16;
typedef unsigned v4u __attribute__((ext_vector_type(4)));
typedef unsigned v2u __attribute__((ext_vector_type(2)));
typedef float f32x4 __attribute__((ext_vector_type(4)));
typedef GAS unsigned gu32;
#define RLX_AGENT __ATOMIC_RELAXED, __HIP_MEMORY_SCOPE_AGENT
#define LDS_WAIT() asm volatile("s_waitcnt lgkmcnt(0)" ::: "memory")
#define VM_WAIT() asm volatile("s_waitcnt vmcnt(0)" ::: "memory")
__device__ __forceinline__ unsigned f2bf(float f) { unsigned u = __builtin_bit_cast(unsigned, f); return (u + 0x7fffu + ((u >> 16) & 1u)) >> 16; }
__device__ __forceinline__ unsigned pk2(float lo, float hi) { return f2bf(lo) | (f2bf(hi) << 16); }
__device__ __forceinline__ float bf2f(unsigned short b) { return __builtin_bit_cast(float, (unsigned)b << 16); }
__device__ __forceinline__ float bflo(unsigned w) { return __builtin_bit_cast(float, w << 16); }
__device__ __forceinline__ float bfhi(unsigned w) { return __builtin_bit_cast(float, w & 0xffff0000u); }
__device__ __forceinline__ float wave_sum(float v) {
#pragma unroll
    for (int o = 1; o < 64; o <<= 1) v += __shfl_xor(v, o);
    return v;
}
__device__ __forceinline__ float wave_max(float v) {
#pragma unroll
    for (int o = 1; o < 64; o <<= 1) v = fmaxf(v, __shfl_xor(v, o));
    return v;
}
#define XB_TMO      128
#define XB_XCNT(j)  (256  + 64 * (j))
#define XB_XSUB(j)  (1280 + 64 * (j))
#define XB_XGEN(j)  (2304 + 64 * (j))
#define XB_TOP      3328
#define XB_TOPGEN   3392
#define XCD_BAR_WORDS 3456
#define XB_SPIN_CAP (1u << 18)

__device__ __forceinline__ unsigned xb_ld(unsigned* p)              { return __hip_atomic_load(p, __ATOMIC_RELAXED, __HIP_MEMORY_SCOPE_AGENT); }
__device__ __forceinline__ unsigned xb_add(unsigned* p, unsigned v) { return __hip_atomic_fetch_add(p, v, __ATOMIC_RELAXED, __HIP_MEMORY_SCOPE_AGENT); }
__device__ __forceinline__ unsigned xb_xcc_id() { return (unsigned)__builtin_amdgcn_s_getreg((3 << 11) | 20) & 0xFu; }
#define XB_SPIN(cond, bar) do { unsigned _sp = 0; while (cond) { __builtin_amdgcn_s_sleep(1); \
    if ((++_sp & 255u) == 0u) { if (xb_ld(&(bar)[XB_TMO])) break; if (_sp > XB_SPIN_CAP) { atomicAdd(&(bar)[XB_TMO], 1u); break; } } } } while (0)

struct XcdBarrier {
    unsigned* bar; unsigned x;
    volatile LAS unsigned* st;
};

__device__ __forceinline__ XcdBarrier xcd_barrier_post(unsigned* bar, volatile LAS unsigned* st) {
    XcdBarrier b; b.bar = bar; b.x = xb_xcc_id(); b.st = st;
    if (threadIdx.x == 0) (void)xb_add(&bar[XB_XCNT(b.x)], 1u);
    return b;
}
__device__ __forceinline__ void xcd_barrier_complete(unsigned* bar, unsigned x, unsigned& nloc, unsigned& nx) {
    const unsigned G = gridDim.x * gridDim.y * gridDim.z;
    unsigned sum, cnt, mine, sp = 0u;
    for (;;) {
        sum = 0u; cnt = 0u; mine = 0u;
#pragma unroll
        for (unsigned j = 0; j < 16; ++j) { const unsigned c = xb_ld(&bar[XB_XCNT(j)]); sum += c; cnt += (c > 0u) ? 1u : 0u; mine = (j == x) ? c : mine; }
        if (sum == G) break;
        __builtin_amdgcn_s_sleep(1);
        if ((++sp & 255u) == 0u) { if (xb_ld(&bar[XB_TMO])) break; if (sp > XB_SPIN_CAP) { atomicAdd(&bar[XB_TMO], 1u); break; } }
    }
    nloc = mine > 0u ? mine : 1u; nx = cnt > 0u ? cnt : 1u;
}

__device__ __forceinline__ void xcd_barrier(const XcdBarrier& b) {
    asm volatile("s_waitcnt vmcnt(0)" ::: "memory");
    __syncthreads();
    if (threadIdx.x == 0) {
        unsigned* bar = b.bar;
        __builtin_amdgcn_s_waitcnt(0);
        unsigned nloc = b.st[0], nx = b.st[1];
        if (nloc == 0u) { xcd_barrier_complete(bar, b.x, nloc, nx); b.st[0] = nloc; b.st[1] = nx; }
        const unsigned old = xb_add(&bar[XB_XSUB(b.x)], 1u);
        const unsigned gen = old / nloc;
        if (old + 1u == (gen + 1u) * nloc) {
            __builtin_amdgcn_fence(__ATOMIC_RELEASE, "agent");
            asm volatile("s_waitcnt vmcnt(0)" ::: "memory");
            const unsigned og = xb_add(&bar[XB_TOP], 1u);
            const unsigned tg = og / nx;
            if (og + 1u == (tg + 1u) * nx) xb_add(&bar[XB_TOPGEN], 1u);
            else XB_SPIN(xb_ld(&bar[XB_TOPGEN]) == tg, bar);
            __builtin_amdgcn_fence(__ATOMIC_ACQUIRE, "agent");
            xb_add(&bar[XB_XGEN(b.x)], 1u);
            asm volatile("s_waitcnt vmcnt(0)" ::: "memory");
        } else {
            XB_SPIN(xb_ld(&bar[XB_XGEN(b.x)]) == gen, bar);
            __builtin_amdgcn_fence(__ATOMIC_ACQUIRE, "agent");
            asm volatile("s_waitcnt vmcnt(0)" ::: "memory");
        }
    }
    __syncthreads();
}

struct Ctx { LAS unsigned char* lds; int tid, lane, wave, vcu, G; const float* in[15]; float* out; unsigned char* ws; };
enum { IN_X = 0, IN_PRE, IN_POST, IN_TAB, IN_NWIN, IN_NWOUT, IN_KPOS, IN_KW1, IN_KW2, IN_VPOS, IN_VW1, IN_VW2, IN_RWIN, IN_RWOUT, IN_GN };

__device__ __forceinline__ int t5_bucket(int d) { int r = 16 + (int)((16.0f / 3.0f) * (__log2f((float)(d < 1 ? 1 : d)) - 4.0f)); r = r > 31 ? 31 : r; return d < 16 ? d : r; }

__device__ __forceinline__ int nsa_src_col(int n) { return n < 2560 ? n : (n < 5632 ? n + 48 : (n < 5680 ? n - 3072 : -1)); }
template <int MODE> __device__ __forceinline__ void convert_item(const float* W, int K, int Nsrc, const float* gain, bf16* WT, LAS float* scr, int item, int nblk, int lane) {
    const int kb = item / nblk, nb = item % nblk, k0 = 64 * kb, n0 = 32 * nb;
    const int n = n0 + (lane & 31), sc = MODE == 1 ? nsa_src_col(n) : n;
#pragma unroll 8
    for (int i = 0; i < 32; ++i) { const int kk = 2 * i + (lane >> 5); float v = 0.f;
        if (sc >= 0) { v = W[(size_t)(k0 + kk) * Nsrc + sc]; if (gain) v *= gain[k0 + kk]; }
        scr[kk * 33 + (lane & 31)] = v; }
    LDS_WAIT();
    const int c = lane & 7;
#pragma unroll
    for (int j = 0; j < 4; ++j) { const int nn = (lane >> 3) + 8 * j; const LAS float* s = scr + (8 * c) * 33 + nn;
        v4u o; o.x = pk2(s[0 * 33], s[1 * 33]); o.y = pk2(s[2 * 33], s[3 * 33]); o.z = pk2(s[4 * 33], s[5 * 33]); o.w = pk2(s[6 * 33], s[7 * 33]);
        *(v4u*)(WT + (size_t)(n0 + nn) * K + k0 + 8 * c) = o; }
    LDS_WAIT();
}
template <int MODE> __device__ __forceinline__ void convert_weights(const Ctx& C, const float* W, int K, int Nsrc, int Ndst, const float* gain, bf16* WT) {
    LAS float* scr = (LAS float*)(C.lds + C.wave * 16384);
    const int gw = C.vcu * NWAVES + C.wave, NGW = C.G * NWAVES, nblk = Ndst / 32, nitems = (K / 64) * nblk;
    for (int it = gw; it < nitems; it += NGW) convert_item<MODE>(W, K, Nsrc, gain, WT, scr, it, nblk, C.lane);
}

__device__ __forceinline__ void p0_rows(const Ctx& C) {
    const int gw = C.vcu * NWAVES + C.wave, NGW = C.G * NWAVES;
    bf16* HB = (bf16*)(C.ws + WS_HB); float* rss = (float*)(C.ws + WS_CTL) + CW_RSS;
    for (int m = gw; m < M; m += NGW) {
        const f32x4* xr = (const f32x4*)(C.in[IN_X] + (size_t)m * D) + C.lane; f32x4 v[4]; float s = 0.f;
#pragma unroll
        for (int j = 0; j < 4; ++j) { v[j] = xr[64 * j]; s += (v[j].x * v[j].x + v[j].y * v[j].y) + (v[j].z * v[j].z + v[j].w * v[j].w); }
        s = wave_sum(s);
        unsigned long long* o8 = (unsigned long long*)(HB + (size_t)m * D) + C.lane;
#pragma unroll
        for (int j = 0; j < 4; ++j) o8[64 * j] = (unsigned long long)pk2(v[j].x, v[j].y) | ((unsigned long long)pk2(v[j].z, v[j].w) << 32);
        if (C.lane == 0) rss[m] = s;
    }
}
__device__ __forceinline__ void p0_tables(const Ctx& C) {
    float* COS = (float*)(C.ws + WS_COS); float* SIN = (float*)(C.ws + WS_SIN);
    for (int idx = C.vcu * NTHR + C.tid; idx < S * 128; idx += C.G * NTHR) {
        const int s = idx >> 7, i = idx & 127;
        const float inv = (float)(1.0 / exp2((double)i * (13.287712379549449 / 127.0)));
        const float ang = (float)s * inv;
        double rev = (double)ang * 0.15915494309189535; rev -= floor(rev + 0.5);
        const float rf = (float)rev;
        COS[idx] = __builtin_amdgcn_cosf(rf); SIN[idx] = __builtin_amdgcn_sinf(rf);
    }
}

__device__ __forceinline__ void naive_compress(const Ctx& C, int slot) {
    LAS float* xs = (LAS float*)(C.lds);
    LAS float* hid = (LAS float*)(C.lds + 32768);
    const bf16* KV = (const bf16*)(C.ws + NSA_KV);
    if (C.vcu == 0) for (int i = C.tid; i < 2 * 32 * 64; i += NTHR) { const int kv = i >> 11, bg = (i >> 6) & 31, d = i & 63;
        ((bf16*)(C.ws + (kv ? NSA_VC : NSA_KC)))[((size_t)bg * 128 + 127) * 64 + d] = 0; }
    for (int unit = C.vcu; unit < 2 * BATCH * NCMP; unit += C.G) {
        const int kv = unit / (BATCH * NCMP), rem = unit % (BATCH * NCMP), b = rem / NCMP, c = rem % NCMP;
        const float* pos = C.in[kv ? IN_VPOS : IN_KPOS] + (size_t)slot * 2048;
        const float* w1 = C.in[kv ? IN_VW1 : IN_KW1] + (size_t)slot * 2048 * 256;
        const float* w2 = C.in[kv ? IN_VW2 : IN_KW2] + (size_t)slot * 256 * 64;
        const bf16* src = KV + (size_t)kv * (16384 * 256);
        bf16* dst = (bf16*)(C.ws + (kv ? NSA_VC : NSA_KC));
        for (int idx = C.tid; idx < 8192; idx += NTHR) { const int g = idx >> 11, k = idx & 2047;
            xs[idx] = bf2f(src[((size_t)((b * 4 + g) * 2048 + 16 * c)) * 64 + k]) + pos[k]; }
        __syncthreads();
        { const int j = C.tid & 255, hf = C.tid >> 8; float a0 = 0.f, a1 = 0.f;
          const LAS float* x0 = xs + (2 * hf) * 2048; const LAS float* x1 = x0 + 2048;
#pragma unroll 4
          for (int k = 0; k < 2048; ++k) { const float w = w1[(size_t)k * 256 + j]; a0 += x0[k] * w; a1 += x1[k] * w; }
          hid[(2 * hf) * 256 + j] = a0 / (1.0f + __expf(-a0)); hid[(2 * hf + 1) * 256 + j] = a1 / (1.0f + __expf(-a1)); }
        __syncthreads();
        if (C.tid < 256) { const int g = C.tid >> 6, d = C.tid & 63; float a = 0.f;
#pragma unroll 4
            for (int j = 0; j < 256; ++j) a += hid[g * 256 + j] * w2[j * 64 + d];
            dst[((size_t)((b * 4 + g) * 128 + c)) * 64 + d] = (bf16)f2bf(a); }
        __syncthreads();
    }
}

__device__ __forceinline__ float dot64(const LAS float* q, const bf16* krow) {
    const v4u* kp = (const v4u*)krow; float s = 0.f;
#pragma unroll
    for (int c = 0; c < 8; ++c) { const v4u w = kp[c]; const LAS float* qq = q + c * 8;
        s += qq[0] * bflo(w.x) + qq[1] * bfhi(w.x) + qq[2] * bflo(w.y) + qq[3] * bfhi(w.y) + qq[4] * bflo(w.z) + qq[5] * bfhi(w.z) + qq[6] * bflo(w.w) + qq[7] * bfhi(w.w); }
    return s;
}
struct SoftAcc { float m, l, o; };
__device__ __forceinline__ void attn_block(SoftAcc& a, const LAS float* q, LAS float* pw, const bf16* Kblk, const bf16* Vblk, float bias, bool valid, int lane) {
    const float lg = valid ? dot64(q, Kblk + lane * 64) * 0.125f + bias : -1e30f;
    const float bm = wave_max(lg);
    if (bm <= -1e29f) return;
    const float mn = fmaxf(a.m, bm), sc = __expf(a.m - mn), p = valid ? __expf(lg - mn) : 0.f;
    a.l = a.l * sc + wave_sum(p); a.o *= sc; a.m = mn;
    pw[lane] = p; LDS_WAIT();
    float o = a.o;
#pragma unroll 8
    for (int k = 0; k < 64; ++k) o += pw[k] * bf2f(Vblk[k * 64 + lane]);
    a.o = o; LDS_WAIT();
}
__device__ __forceinline__ void naive_nsa_attn(const Ctx& C) {
    LAS float* lut = (LAS float*)(C.lds);
    LAS float* qs = (LAS float*)(C.lds + 8448);
    LAS float* pc = (LAS float*)(C.lds + 10496);
    LAS float* pwA = (LAS float*)(C.lds + 14592);
    const float* tab = C.in[IN_TAB];
    for (int i = C.tid; i < 16 * 129; i += NTHR) { const int h = i / 129, d = i % 129; lut[i] = tab[t5_bucket(d) * 16 + h]; }
    __syncthreads();
    bf16* Q = (bf16*)(C.ws + NSA_Q); const bf16* KV = (const bf16*)(C.ws + NSA_KV); const bf16* Z = (const bf16*)(C.ws + NSA_Z); const float* GT = (const float*)(C.ws + NSA_GT);
    const bf16* KC = (const bf16*)(C.ws + NSA_KC); const bf16* VC = (const bf16*)(C.ws + NSA_VC);
    const int w = C.wave, lane = C.lane;
    LAS float* q = qs + w * 64; LAS float* pw = pwA + w * 64; LAS float* pcw = pc + w * 128;
    for (int unit = C.vcu; unit < BATCH * S * 2; unit += C.G) {
        const int b = unit >> 12, rem = unit & 4095, t = rem >> 1, gp = rem & 1, g = gp * 2 + (w >> 2), h = g * 4 + (w & 3);
        const int row = b * S + t;
        const LAS float* lh = lut + h * 129;
        q[lane] = bf2f(Q[(size_t)row * 1024 + h * 64 + lane]); LDS_WAIT();
        const size_t gofs = (size_t)(b * 4 + g);
        float o_cmp;
        { const bf16* KCb = KC + gofs * 128 * 64; const bf16* VCb = VC + gofs * 128 * 64;
          const int e0 = 16 * lane + 31, e1 = 16 * (64 + lane) + 31; const bool v0 = e0 <= t, v1 = (lane < 63) && (e1 <= t);
          const int d0 = t - e0, d1 = t - e1;
          const float lg0 = v0 ? dot64(q, KCb + lane * 64) * 0.125f + lh[d0 > 128 ? 128 : (d0 < 0 ? 0 : d0)] : -1e30f;
          const float lg1 = v1 ? dot64(q, KCb + (64 + lane) * 64) * 0.125f + lh[d1 > 128 ? 128 : (d1 < 0 ? 0 : d1)] : -1e30f;
          const float mx = wave_max(fmaxf(lg0, lg1));
          float p0 = v0 ? __expf(lg0 - mx) : 0.f, p1 = v1 ? __expf(lg1 - mx) : 0.f;
          const float l = wave_sum(p0 + p1), inv = l > 0.f ? 1.0f / l : 0.f;
          p0 *= inv; p1 *= inv; pcw[lane] = p0; pcw[64 + lane] = p1; LDS_WAIT();
          float o = 0.f;
#pragma unroll 8
          for (int c = 0; c < NCMP; ++c) o += pcw[c] * bf2f(VCb[c * 64 + lane]);
          o_cmp = o; }
        __syncthreads();
        unsigned selmask;
        { const int j = lane & 31, cur = t >> 6; float imp = 0.f; const LAS float* pg = pc + (w & 4) * 128;
          const int clo = 4 * j - 1 < 0 ? 0 : 4 * j - 1, chi = 4 * j + 3 > 126 ? 126 : 4 * j + 3;
          for (int r = 0; r < 4; ++r) for (int c = clo; c <= chi; ++c) imp += pg[r * 128 + c];
          const bool valid = j <= cur, forced = (j == 0) || (j == cur) || (j == cur - 1);
          const float score = valid ? imp + (forced ? 1000.0f : 0.f) : -1e30f;
          int rank = 0;
          for (int i = 0; i < 32; ++i) { const float si = __shfl(score, i); rank += ((si > score) || (si == score && i < j)) ? 1 : 0; }
          selmask = (unsigned)(__ballot(rank < 16) & 0xffffffffull); }
        __syncthreads();
        const int cur = t >> 6;
        SoftAcc as{-1e30f, 0.f, 0.f};
        { const bf16* Kb = KV + (size_t)2 * (16384 * 256) + gofs * 2048 * 64; const bf16* Vb = KV + (size_t)3 * (16384 * 256) + gofs * 2048 * 64;
          for (int j = 0; j <= cur; ++j) if ((selmask >> j) & 1u) { const int pos = 64 * j + lane, dist = t - pos;
              attn_block(as, q, pw, Kb + (size_t)j * 4096, Vb + (size_t)j * 4096, lh[dist > 128 ? 128 : (dist < 0 ? 0 : dist)], dist >= 0, lane); } }
        SoftAcc aw{-1e30f, 0.f, 0.f};
        { const bf16* Kb = KV + (size_t)4 * (16384 * 256) + gofs * 2048 * 64; const bf16* Vb = KV + (size_t)5 * (16384 * 256) + gofs * 2048 * 64;
          const int jlo = (t - 511 < 0 ? 0 : t - 511) >> 6;
          for (int j = jlo; j <= cur; ++j) { const int pos = 64 * j + lane, dist = t - pos;
              attn_block(aw, q, pw, Kb + (size_t)j * 4096, Vb + (size_t)j * 4096, lh[dist > 128 ? 128 : (dist < 0 ? 0 : dist)], dist >= 0 && dist < 512, lane); } }
        const float o_slc = as.l > 0.f ? as.o / as.l : 0.f, o_win = aw.l > 0.f ? aw.o / aw.l : 0.f;
        const float* gt = GT + (size_t)row * 48; const bf16* zr = Z + (size_t)row * 3072 + h * 64 + lane;
        const float y = gt[h] * o_cmp * bf2f(zr[0]) + gt[16 + h] * o_slc * bf2f(zr[1024]) + gt[32 + h] * o_win * bf2f(zr[2048]);
        Q[(size_t)row * 1024 + h * 64 + lane] = (bf16)f2bf(y);
    }
}

__device__ __forceinline__ void naive_retention(const Ctx& C, int slot) {
    LAS float* qs = (LAS float*)(C.lds);
    LAS float* as = (LAS float*)(C.lds + 8192);
    LAS float* red = (LAS float*)(C.lds + 8192 + 65536);
    const bf16* Qr = (const bf16*)(C.ws + RET_Q); const bf16* Kr = (const bf16*)(C.ws + RET_K); const bf16* Vr = (const bf16*)(C.ws + RET_V); bf16* Zr = (bf16*)(C.ws + RET_Z);
    const float* gn = C.in[IN_GN] + (size_t)slot * 2048;
    const int tid = C.tid, lane = C.lane, w = C.wave;
    for (int unit = C.vcu; unit < BATCH * 4 * 256; unit += C.G) {
        const int b = unit >> 10, h = (unit >> 8) & 3, t0 = (unit & 255) * 8, tmax = t0 + 7;
        for (int idx = tid; idx < 2048; idx += NTHR) { const int i = idx >> 8, d = idx & 255; qs[idx] = bf2f(Qr[(size_t)(b * S + t0 + i) * 1024 + h * 256 + d]); }
        __syncthreads();
        const float lg = __log2f(1.0f - exp2f(-5.0f - (float)h));
        for (int s = tid; s <= tmax; s += NTHR) {
            const v4u* kp = (const v4u*)(Kr + (size_t)(b * S + s) * 1024 + h * 256);
            float acc[8];
#pragma unroll
            for (int i = 0; i < 8; ++i) acc[i] = 0.f;
#pragma unroll 2
            for (int c = 0; c < 32; ++c) { const v4u kw = kp[c];
                const float k0 = bflo(kw.x), k1 = bfhi(kw.x), k2 = bflo(kw.y), k3 = bfhi(kw.y), k4 = bflo(kw.z), k5 = bfhi(kw.z), k6 = bflo(kw.w), k7 = bfhi(kw.w);
#pragma unroll
                for (int i = 0; i < 8; ++i) { const LAS float* qq = qs + i * 256 + c * 8;
                    acc[i] += qq[0] * k0 + qq[1] * k1 + qq[2] * k2 + qq[3] * k3 + qq[4] * k4 + qq[5] * k5 + qq[6] * k6 + qq[7] * k7; } }
#pragma unroll
            for (int i = 0; i < 8; ++i) { const int dist = t0 + i - s; as[i * 2048 + s] = dist >= 0 ? acc[i] * exp2f((float)dist * lg) : 0.f; }
        }
        __syncthreads();
        float o[8];
#pragma unroll
        for (int i = 0; i < 8; ++i) o[i] = 0.f;
        { const bf16* vp = Vr + (size_t)(b * S) * 2048 + h * 512 + tid;
#pragma unroll 4
          for (int s = 0; s <= tmax; ++s) { const float vv = bf2f(vp[(size_t)s * 2048]);
#pragma unroll
              for (int i = 0; i < 8; ++i) o[i] += as[i * 2048 + s] * vv; } }
        float mu[8];
#pragma unroll
        for (int i = 0; i < 8; ++i) { const float sm = wave_sum(o[i]); if (lane == 0) red[w * 8 + i] = sm; }
        __syncthreads();
#pragma unroll
        for (int i = 0; i < 8; ++i) { float sm = 0.f;
#pragma unroll
            for (int ww = 0; ww < 8; ++ww) sm += red[ww * 8 + i];
            mu[i] = sm * (1.0f / 512.0f); }
        __syncthreads();
#pragma unroll
        for (int i = 0; i < 8; ++i) { const float d = o[i] - mu[i]; const float sq = wave_sum(d * d); if (lane == 0) red[w * 8 + i] = sq; }
        __syncthreads();
#pragma unroll
        for (int i = 0; i < 8; ++i) { float sq = 0.f;
#pragma unroll
            for (int ww = 0; ww < 8; ++ww) sq += red[ww * 8 + i];
            const float rstd = rsqrtf(sq * (1.0f / 512.0f) + GN_EPS);
            const size_t idx = (size_t)(b * S + t0 + i) * 2048 + h * 512 + tid;
            Zr[idx] = (bf16)f2bf((o[i] - mu[i]) * rstd * gn[h * 512 + tid] * bf2f(Zr[idx])); }
        __syncthreads();
    }
}

__device__ __forceinline__ void naive_norm_res(const Ctx& C, int layer, const float* YO) {
    const int gw = C.vcu * NWAVES + C.wave, NGW = C.G * NWAVES;
    bf16* HB = (bf16*)(C.ws + WS_HB); float* rss = (float*)(C.ws + WS_CTL) + CW_RSS + (size_t)(layer + 1) * 16384;
    const float* hp = layer == 0 ? C.in[IN_X] : C.out; const float* gain = C.in[IN_POST] + (size_t)layer * D;
    for (int m = gw; m < M; m += NGW) {
        const f32x4* yr = (const f32x4*)(YO + (size_t)m * D) + C.lane; f32x4 v[4]; float s = 0.f;
#pragma unroll
        for (int j = 0; j < 4; ++j) { v[j] = yr[64 * j]; s += (v[j].x * v[j].x + v[j].y * v[j].y) + (v[j].z * v[j].z + v[j].w * v[j].w); }
        const float rstd = rsqrtf(wave_sum(s) * (1.0f / 1024.0f) + RMS_EPS);
        const f32x4* hr = (const f32x4*)(hp + (size_t)m * D) + C.lane; const f32x4* gr = (const f32x4*)gain + C.lane;
        f32x4* orow = (f32x4*)(C.out + (size_t)m * D) + C.lane;
        unsigned long long* o8 = (unsigned long long*)(HB + (size_t)m * D) + C.lane; float s2 = 0.f;
#pragma unroll
        for (int j = 0; j < 4; ++j) { const f32x4 hn = hr[64 * j] + v[j] * rstd * gr[64 * j]; orow[64 * j] = hn;
            s2 += (hn.x * hn.x + hn.y * hn.y) + (hn.z * hn.z + hn.w * hn.w);
            o8[64 * j] = (unsigned long long)pk2(hn.x, hn.y) | ((unsigned long long)pk2(hn.z, hn.w) << 32); }
        s2 = wave_sum(s2);
        if (C.lane == 0) rss[m] = s2;
    }
}
namespace nsa {
typedef short bf16x8 __attribute__((ext_vector_type(8)));
typedef short s16x4 __attribute__((ext_vector_type(4)));
typedef float f32x16 __attribute__((ext_vector_type(16)));
constexpr int KB0 = 0, VB0 = 8192, LUT_OFF = 32768, GE_OFF = 49152, SC_OFF = 114688, SELM_OFF = 116736;
constexpr float LOG2E = 1.4426950408889634f, SC2 = 0.125f * 1.4426950408889634f;
constexpr size_t TS = (size_t)16384 * 256;
typedef float f32x2_t __attribute__((ext_vector_type(2))); typedef __bf16 bf16x2_t __attribute__((ext_vector_type(2)));
__device__ __forceinline__ unsigned cvtpk(float lo, float hi) { f32x2_t v = {lo, hi}; bf16x2_t b = __builtin_convertvector(v, bf16x2_t); return __builtin_bit_cast(unsigned, b); }
__device__ __forceinline__ s16x4 vtr(const LAS unsigned char* p) { typedef short v4i16_t __attribute__((ext_vector_type(4))); return __builtin_bit_cast(s16x4, __builtin_amdgcn_ds_read_tr16_b64_v4i16((LAS v4i16_t*)p)); }
__device__ __forceinline__ float xhalf_max(float m) { auto rr = __builtin_amdgcn_permlane32_swap(__float_as_uint(m), __float_as_uint(m), false, false); return fmaxf(__uint_as_float(rr[0]), __uint_as_float(rr[1])); }
__device__ __forceinline__ float xhalf_sum(float m) { auto rr = __builtin_amdgcn_permlane32_swap(__float_as_uint(m), __float_as_uint(m), false, false); return __uint_as_float(rr[0]) + __uint_as_float(rr[1]); }
__device__ __forceinline__ int koff(int i) { return (i & 3) + 8 * (i >> 2); }

struct Soft { float m, l; f32x16 o0, o1; };

__device__ __forceinline__ void attn_tile(Soft& st, const LAS unsigned char* Kb, const LAS unsigned char* Vb, const bf16x8 (&qf)[4], const unsigned (&kof)[4], unsigned vof0, unsigned vof1,
                                          int kind, int base_d, bool sel, const LAS float* lutp, float lut128, LAS float* ge, int gj0, float& alpha_out) {
    f32x16 s0, s1;
#pragma unroll
    for (int i = 0; i < 16; ++i) { s0[i] = 0.f; s1[i] = 0.f; }
#pragma unroll
    for (int ks = 0; ks < 4; ++ks) {
        const bf16x8 a0 = *(const LAS bf16x8*)(Kb + kof[ks]), a1 = *(const LAS bf16x8*)(Kb + kof[ks] + 4096);
        s0 = __builtin_amdgcn_mfma_f32_32x32x16_bf16(a0, qf[ks], s0, 0, 0, 0);
        s1 = __builtin_amdgcn_mfma_f32_32x32x16_bf16(a1, qf[ks], s1, 0, 0, 0);
    }
    const float NEG = -INFINITY;
    if (kind == 0) {
#pragma unroll
        for (int i = 0; i < 16; ++i) { const int d0 = base_d - 16 * koff(i), d1 = d0 - 512;
            const float b0 = lutp[d0 > 128 ? 128 : (d0 < 0 ? 0 : d0)], b1 = lutp[d1 > 128 ? 128 : (d1 < 0 ? 0 : d1)];
            s0[i] = d0 >= 0 ? s0[i] * SC2 + b0 : NEG; s1[i] = d1 >= 0 ? s1[i] * SC2 + b1 : NEG; }
    } else if (kind == 1) {
#pragma unroll
        for (int i = 0; i < 16; ++i) { const int d0 = base_d - koff(i), d1 = d0 - 32;
            const float b0 = lutp[d0 > 128 ? 128 : (d0 < 0 ? 0 : d0)], b1 = lutp[d1 > 128 ? 128 : (d1 < 0 ? 0 : d1)];
            s0[i] = (d0 >= 0 && sel) ? s0[i] * SC2 + b0 : NEG; s1[i] = (d1 >= 0 && sel) ? s1[i] * SC2 + b1 : NEG; }
    } else if (kind == 2) {
        const float cb = sel ? lut128 : NEG;
#pragma unroll
        for (int i = 0; i < 16; ++i) { s0[i] = s0[i] * SC2 + cb; s1[i] = s1[i] * SC2 + cb; }
    } else {
#pragma unroll
        for (int i = 0; i < 16; ++i) { const int d0 = base_d - koff(i), d1 = d0 - 32;
            s0[i] = d0 < 512 ? s0[i] * SC2 + lut128 : NEG; s1[i] = d1 < 512 ? s1[i] * SC2 + lut128 : NEG; }
    }
    float bm = fmaxf(s0[0], s1[0]);
#pragma unroll
    for (int i = 1; i < 16; ++i) bm = fmaxf(bm, fmaxf(s0[i], s1[i]));
    bm = xhalf_max(bm);
    const float mn = fmaxf(st.m, bm), alpha = __builtin_amdgcn_exp2f(st.m - mn);
    st.m = mn; alpha_out = alpha;
    float ps = 0.f;
#pragma unroll
    for (int i = 0; i < 16; ++i) { s0[i] = __builtin_amdgcn_exp2f(s0[i] - mn); s1[i] = __builtin_amdgcn_exp2f(s1[i] - mn); ps += s0[i] + s1[i]; }
    st.l = st.l * alpha + ps;
#pragma unroll
    for (int i = 0; i < 16; ++i) { st.o0[i] *= alpha; st.o1[i] *= alpha; }
    if (ge) {
#pragma unroll
        for (int m4 = 0; m4 < 4; ++m4) {
            ge[gj0 + 2 * m4] = (s0[4 * m4] + s0[4 * m4 + 1]) + (s0[4 * m4 + 2] + s0[4 * m4 + 3]); ge[8192 + gj0 + 2 * m4] = s0[4 * m4 + 3];
            ge[gj0 + 8 + 2 * m4] = (s1[4 * m4] + s1[4 * m4 + 1]) + (s1[4 * m4 + 2] + s1[4 * m4 + 3]); ge[8192 + gj0 + 8 + 2 * m4] = s1[4 * m4 + 3]; }
    }
    bf16x8 pf[4];
#pragma unroll
    for (int sp = 0; sp < 4; ++sp) {
        v4u w;
        if (sp < 2) { w.x = cvtpk(s0[8 * sp], s0[8 * sp + 1]); w.y = cvtpk(s0[8 * sp + 2], s0[8 * sp + 3]); w.z = cvtpk(s0[8 * sp + 4], s0[8 * sp + 5]); w.w = cvtpk(s0[8 * sp + 6], s0[8 * sp + 7]); }
        else { const int q = sp - 2; w.x = cvtpk(s1[8 * q], s1[8 * q + 1]); w.y = cvtpk(s1[8 * q + 2], s1[8 * q + 3]); w.z = cvtpk(s1[8 * q + 4], s1[8 * q + 5]); w.w = cvtpk(s1[8 * q + 6], s1[8 * q + 7]); }
        pf[sp] = __builtin_bit_cast(bf16x8, w);
    }
#pragma unroll
    for (int sp = 0; sp < 4; ++sp) {
        const s16x4 l0 = vtr(Vb + vof0 + 2048 * sp), h0 = vtr(Vb + vof0 + 2048 * sp + 1024), l1 = vtr(Vb + vof1 + 2048 * sp), h1 = vtr(Vb + vof1 + 2048 * sp + 1024);
        const bf16x8 v0 = (bf16x8){l0[0], l0[1], l0[2], l0[3], h0[0], h0[1], h0[2], h0[3]}, v1 = (bf16x8){l1[0], l1[1], l1[2], l1[3], h1[0], h1[1], h1[2], h1[3]};
        st.o0 = __builtin_amdgcn_mfma_f32_32x32x16_bf16(v0, pf[sp], st.o0, 0, 0, 0);
        st.o1 = __builtin_amdgcn_mfma_f32_32x32x16_bf16(v1, pf[sp], st.o1, 0, 0, 0);
    }
}

__device__ __forceinline__ void nsa_attn_phase(const Ctx& C) {
    LAS unsigned char* L = C.lds;
    LAS float* lut2 = (LAS float*)(L + LUT_OFF); LAS float* GE = (LAS float*)(L + GE_OFF); LAS float* SCp = (LAS float*)(L + SC_OFF); LAS unsigned* SELM = (LAS unsigned*)(L + SELM_OFF);
    const float* tab = C.in[IN_TAB];
    for (int i = C.tid; i < 16 * 129; i += NTHR) { const int h = i / 129, d = i % 129; lut2[i] = tab[t5_bucket(d) * 16 + h] * LOG2E; }
    __syncthreads();
    bf16* Q = (bf16*)(C.ws + NSA_Q); const bf16* KV = (const bf16*)(C.ws + NSA_KV); const bf16* Z = (const bf16*)(C.ws + NSA_Z); const float* GT = (const float*)(C.ws + NSA_GT);
    const bf16* KC = (const bf16*)(C.ws + NSA_KC); const bf16* VC = (const bf16*)(C.ws + NSA_VC);
    const int tid = C.tid, w = C.wave, lane = C.lane, c = lane & 31, hh = lane >> 5, r4 = w & 3, th = w >> 2, tok = 32 * th + c;
    unsigned kof[4];
#pragma unroll
    for (int ks = 0; ks < 4; ++ks) kof[ks] = (unsigned)(c * 128 + (((2 * ks + hh) ^ ((c >> 1) & 7)) << 4));
    const int gidx = lane >> 4, q4 = (lane >> 2) & 3, p4 = lane & 3, vb_ = (q4 >> 1) & 1;
    const unsigned vcom = (unsigned)((4 * hh + q4) * 128 + ((2 * (gidx & 1) + (p4 >> 1)) << 4) + (p4 & 1) * 8);
    const unsigned vof0 = vcom + 64u * (unsigned)(0 ^ vb_), vof1 = vcom + 64u * (unsigned)(1 ^ vb_);
    const int srow = tid >> 3, sch = tid & 7;
    const unsigned kst = (unsigned)(srow * 128 + ((sch ^ ((srow >> 1) & 7)) << 4)), vst = (unsigned)(8192 + srow * 128 + ((sch ^ (((srow >> 1) & 1) << 2)) << 4));
    for (int ui = C.vcu; ui < 1024; ui += C.G) {
        const int v = ui & 255, n = ui >> 8, k16 = v & 15;
        const int bg = (n < 2 ? 0 : 16) + (v >> 4), qt = n == 0 ? k16 : (n == 1 ? 31 - k16 : (n == 2 ? 15 - k16 : 16 + k16));
        const int b = bg >> 2, g = bg & 3, h = 4 * g + r4, t = 64 * qt + tok, row = b * S + t;
        bf16x8 qf[4];
#pragma unroll
        for (int ks = 0; ks < 4; ++ks) qf[ks] = *(const bf16x8*)(Q + (size_t)row * 1024 + h * 64 + 16 * ks + 8 * hh);
        const LAS float* lutp = lut2 + h * 129; const float lut128 = lutp[128];
        const bf16* KCb = KC + (size_t)bg * 128 * 64; const bf16* VCb = VC + (size_t)bg * 128 * 64;
        const bf16* KSb = KV + 2 * TS + (size_t)bg * 2048 * 64; const bf16* VSb = KV + 3 * TS + (size_t)bg * 2048 * 64;
        const bf16* KWb = KV + 4 * TS + (size_t)bg * 2048 * 64; const bf16* VWb = KV + 5 * TS + (size_t)bg * 2048 * 64;
        const int nslc = qt + 1, nwin = qt + 1 < 9 ? qt + 1 : 9, wlo = qt + 1 - nwin, ntile = 2 + nslc + nwin;
        const bool need_sel = qt >= 16;
        unsigned mysel = 0xffffffffu;
        Soft st; st.m = -1e30f; st.l = 0.f;
        f32x16 y0, y1;
#pragma unroll
        for (int i = 0; i < 16; ++i) { st.o0[i] = 0.f; st.o1[i] = 0.f; y0[i] = 0.f; y1[i] = 0.f; }
        v4u kreg = ((const v4u*)KCb)[tid], vreg = ((const v4u*)VCb)[tid];
        *(LAS v4u*)(L + kst) = kreg; *(LAS v4u*)(L + vst) = vreg;
        __syncthreads();
        float alpha1 = 1.f;
        for (int i = 0; i < ntile; ++i) {
            const int cb = (i & 1) * 16384, nb = ((i + 1) & 1) * 16384; const bool more = i + 1 < ntile;
            if (more) { const int i1 = i + 1; const bf16* kp; const bf16* vp;
                if (i1 < 2) { kp = KCb + 4096; vp = VCb + 4096; }
                else if (i1 < 2 + nslc) { kp = KSb + (size_t)(i1 - 2) * 4096; vp = VSb + (size_t)(i1 - 2) * 4096; }
                else { const int j = wlo + (i1 - 2 - nslc); kp = KWb + (size_t)j * 4096; vp = VWb + (size_t)j * 4096; }
                kreg = ((const v4u*)kp)[tid]; vreg = ((const v4u*)vp)[tid]; }
            int kind, base_d; bool sel = true; LAS float* ge = nullptr; int gj0 = 0;
            if (i < 2) { kind = 0; base_d = t - 31 - 1024 * i - 64 * hh; if (need_sel) { ge = GE + (r4 * 64 + tok) * 32; gj0 = 16 * i + hh; } }
            else if (i < 2 + nslc) { const int j = i - 2; sel = ((mysel >> j) & 1u) != 0u; base_d = 64 * (qt - j) + tok - 4 * hh; kind = (qt - j <= 2) ? 1 : 2; }
            else { const int j = wlo + (i - 2 - nslc); base_d = 64 * (qt - j) + tok - 4 * hh; kind = (qt - j <= 2) ? 1 : ((qt - j == 8) ? 3 : 2); }
            float al;
            attn_tile(st, L + cb, L + cb + 8192, qf, kof, vof0, vof1, kind, base_d, sel, lutp, lut128, ge, gj0, al);
            if (i == 1) alpha1 = al;
            const bool endb = (i == 1) || (i == 1 + nslc) || (i == ntile - 1);
            if (endb) {
                const int br = i == 1 ? 0 : (i == 1 + nslc ? 1 : 2);
                const float lf = xhalf_sum(st.l), inv = lf > 0.f ? 1.0f / lf : 0.f;
                if (br == 0 && need_sel && hh == 0) { SCp[(r4 * 64 + tok) * 2] = alpha1 * inv; SCp[(r4 * 64 + tok) * 2 + 1] = inv; }
                const float coef = GT[(size_t)row * 48 + br * 16 + h] * inv;
                const bf16* zp = Z + (size_t)row * 3072 + br * 1024 + h * 64 + 4 * hh;
#pragma unroll
                for (int i4 = 0; i4 < 4; ++i4) {
                    const v2u za = *(const v2u*)(zp + 8 * i4), zb = *(const v2u*)(zp + 32 + 8 * i4);
                    y0[4 * i4] += st.o0[4 * i4] * coef * bflo(za.x); y0[4 * i4 + 1] += st.o0[4 * i4 + 1] * coef * bfhi(za.x);
                    y0[4 * i4 + 2] += st.o0[4 * i4 + 2] * coef * bflo(za.y); y0[4 * i4 + 3] += st.o0[4 * i4 + 3] * coef * bfhi(za.y);
                    y1[4 * i4] += st.o1[4 * i4] * coef * bflo(zb.x); y1[4 * i4 + 1] += st.o1[4 * i4 + 1] * coef * bfhi(zb.x);
                    y1[4 * i4 + 2] += st.o1[4 * i4 + 2] * coef * bflo(zb.y); y1[4 * i4 + 3] += st.o1[4 * i4 + 3] * coef * bfhi(zb.y); }
                st.m = -1e30f; st.l = 0.f;
#pragma unroll
                for (int q = 0; q < 16; ++q) { st.o0[q] = 0.f; st.o1[q] = 0.f; }
            }
            if (more) { *(LAS v4u*)(L + nb + kst) = kreg; *(LAS v4u*)(L + nb + vst) = vreg; }
            __syncthreads();
            if (i == 1 && need_sel) {
                const LAS float* Gp = GE; const LAS float* Ep = GE + 8192;
#pragma unroll 1
                for (int k = 0; k < 4; ++k) {
                    const int tk = (tid >> 5) + 16 * k, j = tid & 31; float imp = 0.f;
#pragma unroll
                    for (int r = 0; r < 4; ++r) { const int ro = r * 64 + tk; const float f0 = SCp[ro * 2], f1 = SCp[ro * 2 + 1];
                        imp += Gp[ro * 32 + j] * (j < 16 ? f0 : f1);
                        if (j > 0) imp += Ep[ro * 32 + j - 1] * (j - 1 < 16 ? f0 : f1); }
                    const bool valid = j <= qt, forced = (j == 0) || (j == qt) || (j == qt - 1);
                    const float score = valid ? imp + (forced ? 1000.0f : 0.f) : -1e30f;
                    int rank = 0;
                    for (int i2 = 0; i2 < 32; ++i2) { const float si = __shfl(score, (lane & 32) | i2); rank += ((si > score) || (si == score && i2 < j)) ? 1 : 0; }
                    const unsigned long long bal = __ballot(rank < 16);
                    if ((lane & 31) == 0) SELM[tk] = (unsigned)(lane < 32 ? bal : (bal >> 32));
                }
                __syncthreads();
                mysel = SELM[tok];
            }
        }
        bf16* yp = Q + (size_t)row * 1024 + h * 64 + 4 * hh;
#pragma unroll
        for (int i4 = 0; i4 < 4; ++i4) {
            v2u a, bb; a.x = cvtpk(y0[4 * i4], y0[4 * i4 + 1]); a.y = cvtpk(y0[4 * i4 + 2], y0[4 * i4 + 3]); bb.x = cvtpk(y1[4 * i4], y1[4 * i4 + 1]); bb.y = cvtpk(y1[4 * i4 + 2], y1[4 * i4 + 3]);
            *(v2u*)(yp + 8 * i4) = a; *(v2u*)(yp + 32 + 8 * i4) = bb; }
    }
}
}
namespace ret {
using nsa::bf16x8; using nsa::s16x4; using nsa::f32x16; using nsa::vtr; using nsa::cvtpk; using nsa::koff; using nsa::xhalf_sum;
constexpr int PROW = 1040;
constexpr int P_OFF = 0, VT_OFF = 66560;
constexpr int A_BUF = 40960;
__device__ __forceinline__ v4u scale8(const v4u x, const float f) { v4u o; o.x = cvtpk(bflo(x.x) * f, bfhi(x.x) * f); o.y = cvtpk(bflo(x.y) * f, bfhi(x.y) * f); o.z = cvtpk(bflo(x.z) * f, bfhi(x.z) * f); o.w = cvtpk(bflo(x.w) * f, bfhi(x.w) * f); return o; }
__device__ __forceinline__ bf16x8 mk8(const s16x4 lo, const s16x4 hi) { return (bf16x8){lo[0], lo[1], lo[2], lo[3], hi[0], hi[1], hi[2], hi[3]}; }

__device__ __forceinline__ void ret_pass_a(const Ctx& C) {
    LAS unsigned char* L = C.lds;
    const bf16* Kr = (const bf16*)(C.ws + RET_K); const bf16* Vr = (const bf16*)(C.ws + RET_V); bf16* ST = (bf16*)(C.ws + WS_HB);
    const int tid = C.tid, w = C.wave, lane = C.lane, cl = lane & 31, hh = lane >> 5;
    const int gidx = lane >> 4, q4 = (lane >> 2) & 3, p4 = lane & 3, vb_ = (q4 >> 1) & 1;
    const unsigned vcom = (unsigned)((4 * hh + q4) * 128 + ((2 * (gidx & 1) + (p4 >> 1)) << 4) + (p4 & 1) * 8);
    const unsigned vof0 = 32768u + vcom + 64u * (unsigned)(0 ^ vb_), vof1 = 32768u + vcom + 64u * (unsigned)(1 ^ vb_);
    const unsigned kof = (unsigned)((4 * hh + q4) * 512 + ((w ^ q4) << 6) + 32 * (gidx & 1) + 8 * p4);
    for (int u = C.vcu; u < 256; u += C.G) {
        const int bh = u >> 3, sl = u & 7, b = bh >> 2, h = bh & 3;
        const float lg = __log2f(1.0f - exp2f(-5.0f - (float)h));
        const bf16* kbase = Kr + (size_t)(b * S) * 1024 + h * 256; const bf16* vbase = Vr + (size_t)(b * S) * 2048 + h * 512 + 64 * sl;
        f32x16 a0, a1;
#pragma unroll
        for (int i = 0; i < 16; ++i) { a0[i] = 0.f; a1[i] = 0.f; }
        v4u kr[4], vr;
#define RA_LOAD(T) do { const int tb_ = 64 * (T); _Pragma("unroll") for (int k = 0; k < 4; ++k) { const int p = tid + 512 * k, key = p >> 5, pc = p & 31; kr[k] = *(const v4u*)(kbase + (size_t)(tb_ + key) * 1024 + pc * 8); } \
        { const int key = tid >> 3, ch = tid & 7; vr = scale8(*(const v4u*)(vbase + (size_t)(tb_ + key) * 2048 + ch * 8), __builtin_amdgcn_exp2f((float)(511 - ((tb_ + key) & 511)) * lg)); } } while (0)
#define RA_STORE(BUF) do { _Pragma("unroll") for (int k = 0; k < 4; ++k) { const int p = tid + 512 * k, key = p >> 5, pc = p & 31; *(LAS v4u*)(L + (BUF) + key * 512 + ((((pc >> 2) ^ (key & 3))) << 6) + ((pc & 3) << 4)) = kr[k]; } \
        { const int key = tid >> 3, ch = tid & 7; *(LAS v4u*)(L + (BUF) + 32768 + key * 128 + ((ch ^ (((key >> 1) & 1) << 2)) << 4)) = vr; } } while (0)
        RA_LOAD(0); RA_STORE(0);
        __syncthreads();
        for (int i = 0; i < 24; ++i) {
            const int cb = (i & 1) * A_BUF, nb = ((i + 1) & 1) * A_BUF;
            if (i + 1 < 24) RA_LOAD(i + 1);
#pragma unroll
            for (int sp = 0; sp < 4; ++sp) {
                const bf16x8 ka = mk8(vtr(L + cb + kof + 8192 * sp), vtr(L + cb + kof + 8192 * sp + 4096));
                const bf16x8 v0 = mk8(vtr(L + cb + vof0 + 2048 * sp), vtr(L + cb + vof0 + 2048 * sp + 1024)), v1 = mk8(vtr(L + cb + vof1 + 2048 * sp), vtr(L + cb + vof1 + 2048 * sp + 1024));
                a0 = __builtin_amdgcn_mfma_f32_32x32x16_bf16(ka, v0, a0, 0, 0, 0);
                a1 = __builtin_amdgcn_mfma_f32_32x32x16_bf16(ka, v1, a1, 0, 0, 0);
            }
            if (i + 1 < 24) RA_STORE(nb);
            __syncthreads();
            if ((i & 7) == 7) {
                const int cc = i >> 3;
                bf16* st0 = ST + ((size_t)((bh * 3 + cc) * 512 + 64 * sl + cl)) * 256 + 32 * w + 4 * hh;
#pragma unroll
                for (int i4 = 0; i4 < 4; ++i4) {
                    v2u x, y; x.x = cvtpk(a0[4 * i4], a0[4 * i4 + 1]); x.y = cvtpk(a0[4 * i4 + 2], a0[4 * i4 + 3]); y.x = cvtpk(a1[4 * i4], a1[4 * i4 + 1]); y.y = cvtpk(a1[4 * i4 + 2], a1[4 * i4 + 3]);
                    *(v2u*)(st0 + 8 * i4) = x; *(v2u*)(st0 + (size_t)32 * 256 + 8 * i4) = y; }
                const float dec = __builtin_amdgcn_exp2f(512.0f * lg);
#pragma unroll
                for (int q = 0; q < 16; ++q) { a0[q] *= dec; a1[q] *= dec; }
            }
        }
#undef RA_LOAD
#undef RA_STORE
    }
}

__device__ __forceinline__ void ret_pass_c(const Ctx& C, int slot) {
    LAS unsigned char* L = C.lds;
    const bf16* Qr = (const bf16*)(C.ws + RET_Q); const bf16* Kr = (const bf16*)(C.ws + RET_K); const bf16* Vr = (const bf16*)(C.ws + RET_V); bf16* Zr = (bf16*)(C.ws + RET_Z);
    const bf16* ST = (const bf16*)(C.ws + WS_HB); const float* gn = C.in[IN_GN] + (size_t)slot * 2048;
    const int tid = C.tid, w = C.wave, lane = C.lane, cl = lane & 31, hh = lane >> 5;
    const int gidx = lane >> 4, q4 = (lane >> 2) & 3, p4 = lane & 3, vb_ = (q4 >> 1) & 1;
    const unsigned vcom = (unsigned)(w * 4096 + (8 * hh + q4) * 128 + ((2 * (gidx & 1) + (p4 >> 1)) << 4) + (p4 & 1) * 8);
    const unsigned vof0 = VT_OFF + vcom + 64u * (unsigned)(0 ^ vb_), vof1 = VT_OFF + vcom + 64u * (unsigned)(1 ^ vb_);
    for (int ui = C.vcu; ui < 1024; ui += C.G) {
        const int v = ui & 255, n = ui >> 8, bh = v >> 3, k8 = v & 7, c = n, k3 = (k8 + 3) & 7;
        const int rb8 = n == 0 ? k8 : (n == 1 ? 7 - k8 : (n == 2 ? k3 : 7 - k3));
        const int b = bh >> 2, h = bh & 3;
        const float lg = __log2f(1.0f - exp2f(-5.0f - (float)h));
        const size_t tok0 = (size_t)b * S + 512 * c;
        const int q0 = 64 * rb8;
        {   const int qh = w & 1, iq = q0 + 32 * qh + cl;
            bf16x8 qf[16];
            const bf16* qp = Qr + (tok0 + iq) * 1024 + h * 256 + 8 * hh;
#pragma unroll
            for (int ks = 0; ks < 16; ++ks) qf[ks] = *(const bf16x8*)(qp + 16 * ks);
            float colf[16];
#pragma unroll
            for (int i = 0; i < 16; ++i) colf[i] = __builtin_amdgcn_exp2f(-lg * (float)koff(i));
            for (int kt = w >> 1; kt < 2 * (rb8 + 1); kt += 4) {
                const int kb = 32 * kt;
                const bf16* kp = Kr + (tok0 + kb + cl) * 1024 + h * 256 + 8 * hh;
                f32x16 s;
#pragma unroll
                for (int i = 0; i < 16; ++i) s[i] = 0.f;
#pragma unroll
                for (int ks = 0; ks < 16; ++ks) { const bf16x8 ka = *(const bf16x8*)(kp + 16 * ks); s = __builtin_amdgcn_mfma_f32_32x32x16_bf16(ka, qf[ks], s, 0, 0, 0); }
                const int d0 = iq - kb - 4 * hh; const float rf = __builtin_amdgcn_exp2f(lg * (float)d0);
                LAS unsigned char* pw = L + P_OFF + (32 * qh + cl) * PROW + (kb + 4 * hh) * 2;
#pragma unroll
                for (int i4 = 0; i4 < 4; ++i4) {
                    float p[4];
#pragma unroll
                    for (int e = 0; e < 4; ++e) { const int i = 4 * i4 + e; p[e] = (d0 - koff(i) >= 0) ? s[i] * rf * colf[i] : 0.f; }
                    v2u x; x.x = cvtpk(p[0], p[1]); x.y = cvtpk(p[2], p[3]);
                    *(LAS v2u*)(pw + 16 * i4) = x; }
            }
        }
        f32x16 acc[2][2];
#pragma unroll
        for (int a = 0; a < 2; ++a)
#pragma unroll
            for (int bq = 0; bq < 2; ++bq)
#pragma unroll
                for (int i = 0; i < 16; ++i) acc[a][bq][i] = 0.f;
        const int nvt = 2 * (rb8 + 1);
        const bf16* vsrc = Vr + tok0 * 2048 + h * 512;
        v4u vr[4];
#define RC_LOAD(T) do { _Pragma("unroll") for (int k = 0; k < 4; ++k) { const int p = tid + 512 * k, key = p >> 6, pc = p & 63; vr[k] = *(const v4u*)(vsrc + (size_t)(32 * (T) + key) * 2048 + pc * 8); } } while (0)
#define RC_STORE(BUF) do { _Pragma("unroll") for (int k = 0; k < 4; ++k) { const int p = tid + 512 * k, key = p >> 6, pc = p & 63; \
            *(LAS v4u*)(L + VT_OFF + (BUF) + (pc >> 3) * 4096 + key * 128 + (((pc & 7) ^ (((key >> 1) & 1) << 2)) << 4)) = vr[k]; } } while (0)
        RC_LOAD(0);
        if (c > 0) {
            const bf16* sp0 = ST + ((size_t)((bh * 3 + (c - 1)) * 512 + 64 * w + cl)) * 256 + 8 * hh;
            const bf16* qp0 = Qr + (tok0 + q0 + cl) * 1024 + h * 256 + 8 * hh;
#pragma unroll 4
            for (int ks = 0; ks < 16; ++ks) {
                const bf16x8 s0 = *(const bf16x8*)(sp0 + 16 * ks), s1 = *(const bf16x8*)(sp0 + (size_t)32 * 256 + 16 * ks);
                const bf16x8 b0 = *(const bf16x8*)(qp0 + 16 * ks), b1 = *(const bf16x8*)(qp0 + (size_t)32 * 1024 + 16 * ks);
                acc[0][0] = __builtin_amdgcn_mfma_f32_32x32x16_bf16(s0, b0, acc[0][0], 0, 0, 0); acc[0][1] = __builtin_amdgcn_mfma_f32_32x32x16_bf16(s0, b1, acc[0][1], 0, 0, 0);
                acc[1][0] = __builtin_amdgcn_mfma_f32_32x32x16_bf16(s1, b0, acc[1][0], 0, 0, 0); acc[1][1] = __builtin_amdgcn_mfma_f32_32x32x16_bf16(s1, b1, acc[1][1], 0, 0, 0);
            }
            const float x0 = __builtin_amdgcn_exp2f(lg * (float)(q0 + cl + 1)), x1 = __builtin_amdgcn_exp2f(lg * (float)(q0 + 32 + cl + 1));
#pragma unroll
            for (int i = 0; i < 16; ++i) { acc[0][0][i] *= x0; acc[1][0][i] *= x0; acc[0][1][i] *= x1; acc[1][1][i] *= x1; }
        }
        RC_STORE(0);
        __syncthreads();
        for (int vt = 0; vt < nvt; ++vt) {
            const unsigned cb = (unsigned)(vt & 1) * 32768u, nb = (unsigned)((vt + 1) & 1) * 32768u;
            if (vt + 1 < nvt) RC_LOAD(vt + 1);
#pragma unroll
            for (int sp = 0; sp < 2; ++sp) {
                const bf16x8 v0 = mk8(vtr(L + cb + vof0 + 2048 * sp), vtr(L + cb + vof0 + 2048 * sp + 512)), v1 = mk8(vtr(L + cb + vof1 + 2048 * sp), vtr(L + cb + vof1 + 2048 * sp + 512));
                const LAS unsigned char* pp = L + P_OFF + cl * PROW + (32 * vt + 16 * sp + 8 * hh) * 2;
                const bf16x8 p0 = *(const LAS bf16x8*)(pp), p1 = *(const LAS bf16x8*)(pp + 32 * PROW);
                acc[0][0] = __builtin_amdgcn_mfma_f32_32x32x16_bf16(v0, p0, acc[0][0], 0, 0, 0); acc[0][1] = __builtin_amdgcn_mfma_f32_32x32x16_bf16(v0, p1, acc[0][1], 0, 0, 0);
                acc[1][0] = __builtin_amdgcn_mfma_f32_32x32x16_bf16(v1, p0, acc[1][0], 0, 0, 0); acc[1][1] = __builtin_amdgcn_mfma_f32_32x32x16_bf16(v1, p1, acc[1][1], 0, 0, 0);
            }
            if (vt + 1 < nvt) RC_STORE(nb);
            __syncthreads();
        }
#undef RC_LOAD
#undef RC_STORE
        LAS float* red = (LAS float*)(L + P_OFF);
#pragma unroll
        for (int bq = 0; bq < 2; ++bq) { float s1 = 0.f, s2 = 0.f;
#pragma unroll
            for (int i = 0; i < 16; ++i) { const float x = acc[0][bq][i], y = acc[1][bq][i]; s1 += x + y; s2 += x * x + y * y; }
            s1 = xhalf_sum(s1); s2 = xhalf_sum(s2);
            if (hh == 0) { red[(w * 64 + 32 * bq + cl) * 2] = s1; red[(w * 64 + 32 * bq + cl) * 2 + 1] = s2; } }
        __syncthreads();
#pragma unroll
        for (int bq = 0; bq < 2; ++bq) { float s1 = 0.f, s2 = 0.f;
#pragma unroll
            for (int ww = 0; ww < 8; ++ww) { s1 += red[(ww * 64 + 32 * bq + cl) * 2]; s2 += red[(ww * 64 + 32 * bq + cl) * 2 + 1]; }
            const float mu = s1 * (1.0f / 512.0f), var = fmaxf(s2 * (1.0f / 512.0f) - mu * mu, 0.f), rstd = rsqrtf(var + GN_EPS);
            bf16* zrow = Zr + (tok0 + q0 + 32 * bq + cl) * 2048 + h * 512 + 64 * w + 4 * hh;
            const float* grow = gn + h * 512 + 64 * w + 4 * hh;
#pragma unroll
            for (int a = 0; a < 2; ++a)
#pragma unroll
                for (int i4 = 0; i4 < 4; ++i4) {
                    const v2u z = *(const v2u*)(zrow + 32 * a + 8 * i4); const f32x4 gg = *(const f32x4*)(grow + 32 * a + 8 * i4);
                    const float o0 = (acc[a][bq][4 * i4] - mu) * rstd * gg.x * bflo(z.x), o1 = (acc[a][bq][4 * i4 + 1] - mu) * rstd * gg.y * bfhi(z.x);
                    const float o2 = (acc[a][bq][4 * i4 + 2] - mu) * rstd * gg.z * bflo(z.y), o3 = (acc[a][bq][4 * i4 + 3] - mu) * rstd * gg.w * bfhi(z.y);
                    v2u o; o.x = cvtpk(o0, o1); o.y = cvtpk(o2, o3); *(v2u*)(zrow + 32 * a + 8 * i4) = o; }
        }
        __syncthreads();
    }
}
}
constexpr int PH_PER_PAIR = 10, N_PHASES = 1 + 2 * PH_PER_PAIR;
struct Args { const float* in[15]; float* out; unsigned char* ws; int ph_lo, ph_hi; };
#define IN(k) (lo <= (k) && (k) < hi)
#define SEAM(k) do { if (IN(k) && IN((k) + 1)) xcd_barrier(bar); } while (0)
template <int p> __device__ __forceinline__ void layer_pair(const Ctx& C, const XcdBarrier& bar, const int lo, const int hi) {
    unsigned char* ws = C.ws;
    float* rss_base = (float*)(ws + WS_CTL) + CW_RSS;
    bf16* WIN = (bf16*)(ws + WS_WIN); bf16* WOUT = (bf16*)(ws + WS_WOUT); bf16* HB = (bf16*)(ws + WS_HB);
        const int pb = 1 + PH_PER_PAIR * p, L0 = 2 * p, L1 = 2 * p + 1;
        if (IN(pb + 0)) {
            pg8::Gemm g{HB, WIN, M, NSA_NP, 1024}; pg8::StaticOrder So; So.init(M, NSA_NP, C.G, (int)blockIdx.x);
            pg8::EpiNsaProj E{rss_base + (size_t)L0 * 16384, (bf16*)(ws + NSA_Q), (bf16*)(ws + NSA_KV), (bf16*)(ws + NSA_Z), (float*)(ws + NSA_GT)};
            pg8::gemm_phase<pg8::EpiNsaProj, pg8::StaticOrder, true, true>(C.lds + RING_OFF, g, So, E);
        }
        SEAM(pb + 0);
        if (IN(pb + 1)) {
            convert_weights<0>(C, C.in[IN_NWOUT] + (size_t)p * 1024 * 1024, 1024, 1024, 1024, nullptr, WOUT);
            convert_weights<0>(C, C.in[IN_RWIN] + (size_t)p * 1024 * 6144, 1024, 6144, RET_NP, C.in[IN_PRE] + (size_t)L1 * D, WIN);
            __syncthreads();
            naive_compress(C, p);
        }
        SEAM(pb + 1);
        if (IN(pb + 2)) nsa::nsa_attn_phase(C);
        SEAM(pb + 2);
        if (IN(pb + 3)) {
            pg8::Gemm g{(const bf16*)(ws + NSA_Q), WOUT, M, 1024, 1024}; pg8::StaticOrder So; So.init(M, 1024, C.G, (int)blockIdx.x);
            pg8::EpiF32 E{(float*)(ws + NSA_YO), 1024};
            pg8::gemm_phase<pg8::EpiF32, pg8::StaticOrder, true, true>(C.lds + RING_OFF, g, So, E);
        }
        SEAM(pb + 3);
        if (IN(pb + 4)) naive_norm_res(C, L0, (const float*)(ws + NSA_YO));
        SEAM(pb + 4);
        if (IN(pb + 5)) {
            pg8::Gemm g{HB, WIN, M, RET_NP, 1024}; pg8::StaticOrder So; So.init(M, RET_NP, C.G, (int)blockIdx.x);
            pg8::EpiRetProj E{rss_base + (size_t)L1 * 16384, (const float*)(ws + WS_COS), (const float*)(ws + WS_SIN), (bf16*)(ws + RET_Q), (bf16*)(ws + RET_K), (bf16*)(ws + RET_V), (bf16*)(ws + RET_Z)};
            pg8::gemm_phase<pg8::EpiRetProj, pg8::StaticOrder, true, true>(C.lds + RING_OFF, g, So, E);
        }
        SEAM(pb + 5);
        if (IN(pb + 6)) {
            convert_weights<0>(C, C.in[IN_RWOUT] + (size_t)p * 2048 * 1024, 2048, 1024, 1024, nullptr, WOUT);
            if (p == 0) convert_weights<1>(C, C.in[IN_NWIN] + (size_t)1 * 1024 * 5680, 1024, 5680, NSA_NP, C.in[IN_PRE] + (size_t)2 * D, WIN);
            __syncthreads();
            ret::ret_pass_a(C);
        }
        SEAM(pb + 6);
        if (IN(pb + 7)) ret::ret_pass_c(C, p);
        SEAM(pb + 7);
        if (IN(pb + 8)) {
            pg8::Gemm g{(const bf16*)(ws + RET_Z), WOUT, M, 1024, 2048}; pg8::StaticOrder So; So.init(M, 1024, C.G, (int)blockIdx.x);
            pg8::EpiF32 E{(float*)(ws + RET_YO), 1024};
            pg8::gemm_phase<pg8::EpiF32, pg8::StaticOrder, true, true>(C.lds + RING_OFF, g, So, E);
        }
        SEAM(pb + 8);
        if (IN(pb + 9)) naive_norm_res(C, L1, (const float*)(ws + RET_YO));
        SEAM(pb + 9);
    }
__global__ void __launch_bounds__(NTHR, 2) hybrid_fwd(Args args) {
    extern __shared__ __attribute__((aligned(16))) unsigned char lds[];
    Ctx C;
    C.lds = (LAS unsigned char*)lds;
    C.tid = threadIdx.x; C.lane = C.tid & 63; C.wave = __builtin_amdgcn_readfirstlane(C.tid >> 6);
    C.G = gridDim.x; { const int bx = blockIdx.x; C.vcu = (C.G % 8 == 0) ? (bx % 8) * (C.G / 8) + bx / 8 : bx; }
#pragma unroll
    for (int i = 0; i < 15; ++i) C.in[i] = args.in[i];
    C.out = args.out; C.ws = args.ws;
    unsigned char* ws = args.ws;
    gu32* ctl = (gu32*)(ws + WS_CTL);
    volatile LAS unsigned* MISC = (volatile LAS unsigned*)(C.lds + MISC_OFF);
    for (int u = C.tid; u < (LDS_BYTES - LDSCTL_OFF) / 4; u += NTHR) ((LAS unsigned*)(C.lds + LDSCTL_OFF))[u] = 0u;
    __syncthreads();
    XcdBarrier bar = xcd_barrier_post((unsigned*)(ctl + CW_BAR), MISC + 8);
    const int lo = args.ph_lo, hi = args.ph_hi;
    float* rss_base = (float*)(ws + WS_CTL) + CW_RSS;
    bf16* WIN = (bf16*)(ws + WS_WIN); bf16* WOUT = (bf16*)(ws + WS_WOUT); bf16* HB = (bf16*)(ws + WS_HB);

    if (IN(0)) {
        convert_weights<1>(C, C.in[IN_NWIN], 1024, 5680, NSA_NP, C.in[IN_PRE], WIN);
        p0_rows(C); p0_tables(C);
    }
    SEAM(0);
    layer_pair<0>(C, bar, lo, hi);
    layer_pair<1>(C, bar, lo, hi);
#undef IN
#undef SEAM
}

#ifndef N_LAUNCH_MODE
#define N_LAUNCH_MODE 1
#endif
extern "C" void kernel_launch(void* const* d_in, const int* in_sizes, int n_in, void* d_out, int out_size, void* d_ws, size_t ws_size, hipStream_t stream) {
    static int grid = 0;
    if (grid == 0) {
        if (n_in != 15 || out_size != M * D || ws_size < WS_END) { fprintf(stderr, "kernel_launch: unexpected problem shape (n_in %d, out %d, ws %zu)\n", n_in, out_size, ws_size); grid = -1; return; }
        int dev = 0, cus = 0, per_cu = 0;
        if (hipGetDevice(&dev) != hipSuccess || hipDeviceGetAttribute(&cus, hipDeviceAttributeMultiprocessorCount, dev) != hipSuccess) { grid = -1; return; }
        if (hipFuncSetAttribute((const void*)hybrid_fwd, hipFuncAttributeMaxDynamicSharedMemorySize, LDS_BYTES) != hipSuccess) { fprintf(stderr, "kernel_launch: hipFuncSetAttribute failed\n"); grid = -1; return; }
        if (hipOccupancyMaxActiveBlocksPerMultiprocessor(&per_cu, (const void*)hybrid_fwd, NTHR, LDS_BYTES) != hipSuccess || per_cu < 1) { fprintf(stderr, "kernel_launch: occupancy query reports %d blocks per CU\n", per_cu); }
        (void)hipGetLastError();
        grid = cus;
    }
    if (grid < 0) return;
    if (hipMemsetAsync((char*)d_ws + WS_CTL, 0, CTL_ZERO_BYTES, stream) != hipSuccess) return;
    Args a{};
    for (int i = 0; i < 15; ++i) a.in[i] = (const float*)d_in[i];
    a.out = (float*)d_out; a.ws = (unsigned char*)d_ws;
#if N_LAUNCH_MODE == 1
    a.ph_lo = 0; a.ph_hi = N_PHASES;
    hipLaunchKernelGGL(hybrid_fwd, dim3(grid), dim3(NTHR), LDS_BYTES, stream, a);
#else
    for (int k = 0; k < N_PHASES; ++k) { a.ph_lo = k; a.ph_hi = k + 1; hipLaunchKernelGGL(hybrid_fwd, dim3(grid), dim3(NTHR), LDS_BYTES, stream, a); }
#endif
}
```

```cpp
#include <hip/hip_runtime.h>
#include <cstdio>
#include <cstdint>
namespace pg8 {
#define PG8_LAS __attribute__((address_space(3)))
typedef unsigned short bf16_t;
typedef short bf16x8 __attribute__((ext_vector_type(8)));
typedef float f32x4 __attribute__((ext_vector_type(4)));
typedef unsigned u32x4 __attribute__((ext_vector_type(4)));
constexpr int BM = 256, BK = 64, HALF = 128, HTB = HALF * BK * 2  , STAGE_BYTES = 8 * HTB, NXCD = 8, WGM = 8;

__host__ __device__ __forceinline__ int lds_byte(int r, int c) { const int st = (r >> 4) * 2 + (c >> 5), rr = r & 15, cc = c & 31, ob = rr * 64 + cc * 2; return st * 1024 + (ob ^ (((ob >> 9) & 1) << 5)); }
__host__ __device__ __forceinline__ void stage_rc(int b, int& R, int& C) { const int st = b / 1024, sb = b % 1024, swz = sb ^ (((sb >> 9) & 1) << 5); R = (st >> 1) * 16 + swz / 64; C = (st & 1) * 32 + (swz % 64) / 2; }
__host__ __device__ __forceinline__ int perm32(int rho) { const int n = rho >> 4, i = rho & 15; return 8 * (i >> 2) + 4 * n + (i & 3); }

struct Unit { int pm, pn; };
struct Gemm { const bf16_t* A; const bf16_t* Bt; int M, N, K; };

struct StaticOrder {
    int nM, nN, nwg, G, c;
    __host__ __device__ void init(int M, int N, int G_, int c_) { nM = M / BM; nN = N / BM; nwg = nM * nN; G = G_; c = c_; }
    __host__ __device__ bool next(int i, Unit& u) const {
        const long L = (long)i * G + c; if (L >= nwg) return false;
        int wgid = (int)L; { const int q = nwg / NXCD, r = nwg % NXCD, xcd = wgid % NXCD, off = wgid / NXCD; wgid = (xcd < r ? xcd * (q + 1) : r * (q + 1) + (xcd - r) * q) + off; }
        const int nig = WGM * nN, gid = wgid / nig, fm = gid * WGM, gsz = (nM - fm) < WGM ? (nM - fm) : WGM;
        u.pm = fm + ((wgid % nig) % gsz); u.pn = (wgid % nig) / gsz; return true;
    }
    __device__ __forceinline__ void a_ready(const Unit&) const {}
    __device__ __forceinline__ void done(const Unit&) const {}
};

__device__ __forceinline__ unsigned cvt_pk_bf16(float lo, float hi) { unsigned r; asm volatile("v_cvt_pk_bf16_f32 %0, %1, %2" : "=v"(r) : "v"(lo), "v"(hi)); return r; }
typedef float f32x2 __attribute__((ext_vector_type(2)));
__device__ __forceinline__ float silu_f(float x) { return x / (1.0f + __expf(-x)); }
__device__ __forceinline__ float sigm_f(float x) { return 1.0f / (1.0f + __expf(-x)); }
__device__ __forceinline__ u32x4 pack8(const f32x4 a, const f32x4 b) { u32x4 w; w.x = cvt_pk_bf16(a[0], a[1]); w.y = cvt_pk_bf16(a[2], a[3]); w.z = cvt_pk_bf16(b[0], b[1]); w.w = cvt_pk_bf16(b[2], b[3]); return w; }
struct EpiNsaProj {
    static constexpr bool PERM = true, AFTER_DRAIN = false;
    const float* rss; bf16_t* Q; bf16_t* KV; bf16_t* Z; float* GT;
    __device__ __forceinline__ void operator()(const f32x4 (&acc)[2][2][4][2], const Unit& u, int wr, int wc, int fr, int fq) const {
        const int row0 = u.pm * BM + wr * 64 + fr, cl = wc * 32 + 8 * fq, pn = u.pn;
#pragma unroll
        for (int ai = 0; ai < 2; ++ai)
#pragma unroll
            for (int m = 0; m < 4; ++m) {
                const int row = row0 + ai * HALF + m * 16;
                const float rs = rsqrtf(rss[row] * (1.0f / 1024.0f) + 1e-6f);
#pragma unroll
                for (int bj = 0; bj < 2; ++bj) {
                    const int c = bj * HALF + cl;
                    f32x4 v0 = acc[ai][bj][m][0] * rs, v1 = acc[ai][bj][m][1] * rs;
                    if (pn < 4) { *(u32x4*)(Q + (size_t)row * 1024 + pn * 256 + c) = pack8(v0, v1); }
                    else if (pn < 10) { const int j = pn - 4, g = c >> 6, d = c & 63, b = row >> 11, s = row & 2047;
                        *(u32x4*)(KV + (size_t)j * (16384 * 256) + ((size_t)((b * 4 + g) * 2048 + s)) * 64 + d) = pack8(v0, v1); }
                    else if (pn < 22) {
#pragma unroll
                        for (int e = 0; e < 4; ++e) { v0[e] = silu_f(v0[e]); v1[e] = silu_f(v1[e]); }
                        *(u32x4*)(Z + (size_t)row * 3072 + (pn - 10) * 256 + c) = pack8(v0, v1); }
                    else if (c < 48) {
#pragma unroll
                        for (int e = 0; e < 4; ++e) { v0[e] = sigm_f(v0[e]); v1[e] = sigm_f(v1[e]); }
                        *(f32x4*)(GT + (size_t)row * 48 + c) = v0; *(f32x4*)(GT + (size_t)row * 48 + c + 4) = v1; }
                }
            }
    }
};
struct EpiRetProj {
    static constexpr bool PERM = true, AFTER_DRAIN = false;
    const float* rss; const float* COS; const float* SIN; bf16_t* Q; bf16_t* K; bf16_t* V; bf16_t* Z;
    __device__ __forceinline__ void operator()(const f32x4 (&acc)[2][2][4][2], const Unit& u, int wr, int wc, int fr, int fq) const {
        const int row0 = u.pm * BM + wr * 64 + fr, cl = wc * 32 + 8 * fq, pn = u.pn;
#pragma unroll
        for (int ai = 0; ai < 2; ++ai)
#pragma unroll
            for (int m = 0; m < 4; ++m) {
                const int row = row0 + ai * HALF + m * 16;
                const float rs = rsqrtf(rss[row] * (1.0f / 1024.0f) + 1e-6f);
                if (pn < 8) {
                    const float sc = pn < 4 ? rs : rs * 0.0625f;
                    const int s = row & 2047;
                    const f32x4 c0 = *(const f32x4*)(COS + s * 128 + cl), c1 = *(const f32x4*)(COS + s * 128 + cl + 4);
                    const f32x4 s0 = *(const f32x4*)(SIN + s * 128 + cl), s1 = *(const f32x4*)(SIN + s * 128 + cl + 4);
                    const f32x4 a0 = acc[ai][0][m][0] * sc, a1 = acc[ai][0][m][1] * sc, b0 = acc[ai][1][m][0] * sc, b1 = acc[ai][1][m][1] * sc;
                    const f32x4 o10 = a0 * c0 - b0 * s0, o11 = a1 * c1 - b1 * s1, o20 = a0 * s0 + b0 * c0, o21 = a1 * s1 + b1 * c1;
                    bf16_t* base = (pn < 4 ? Q : K) + (size_t)row * 1024 + (pn & 3) * 256 + cl;
                    *(u32x4*)(base) = pack8(o10, o11); *(u32x4*)(base + 128) = pack8(o20, o21);
                } else {
#pragma unroll
                    for (int bj = 0; bj < 2; ++bj) {
                        const int c = bj * HALF + cl;
                        f32x4 v0 = acc[ai][bj][m][0] * rs, v1 = acc[ai][bj][m][1] * rs;
                        if (pn < 16) { *(u32x4*)(V + (size_t)row * 2048 + (pn - 8) * 256 + c) = pack8(v0, v1); }
                        else {
#pragma unroll
                            for (int e = 0; e < 4; ++e) { v0[e] = silu_f(v0[e]); v1[e] = silu_f(v1[e]); }
                            *(u32x4*)(Z + (size_t)row * 2048 + (pn - 16) * 256 + c) = pack8(v0, v1); }
                    }
                }
            }
    }
};
struct EpiF32 {
    static constexpr bool PERM = true, AFTER_DRAIN = false;
    float* O; int ldc;
    __device__ __forceinline__ void operator()(const f32x4 (&acc)[2][2][4][2], const Unit& u, int wr, int wc, int fr, int fq) const {
        const int row0 = u.pm * BM + wr * 64 + fr, cl = u.pn * BM + wc * 32 + 8 * fq;
#pragma unroll
        for (int ai = 0; ai < 2; ++ai)
#pragma unroll
            for (int m = 0; m < 4; ++m)
#pragma unroll
                for (int bj = 0; bj < 2; ++bj) { float* p = O + (size_t)(row0 + ai * HALF + m * 16) * ldc + cl + bj * HALF;
                    *(f32x4*)p = acc[ai][bj][m][0]; *(f32x4*)(p + 4) = acc[ai][bj][m][1]; }
    }
};

template <class Epi, class Sched, bool ALIGN_EPI = false, bool SP2 = false>
__device__ __forceinline__ void gemm_phase(PG8_LAS unsigned char* lds, const Gemm g, const Sched& S, const Epi& E) {
    const int tid = threadIdx.x, wid = __builtin_amdgcn_readfirstlane(tid >> 6), lane = tid & 63, wr = wid >> 2, wc = wid & 3, fr = lane & 15, fq = lane >> 4;
    const int K = g.K, nt = K / BK;
    unsigned voffA[2], voffB[2];
#pragma unroll
    for (int i = 0; i < 2; ++i) { int R, C; stage_rc(tid * 16 + i * 8192, R, C); const int Rb = Epi::PERM ? ((R & ~31) + perm32(R & 31)) : R;
        voffA[i] = (unsigned)(R * K + C) * 2u; voffB[i] = (unsigned)(Rb * K + C) * 2u; }
    const size_t kstep = (size_t)(BK * 2);
    const size_t hstep = (size_t)HALF * K * 2;
    const size_t tstep = 2 * hstep;
    const unsigned ldsw = (unsigned)wid * 1024u;
    const int aoff = lds_byte(wr * 64 + fr, fq * 8), boff = lds_byte(wc * 32 + fr, fq * 8);
#define PG8_SA(b, h) (((b) * 2 + (h)) * HTB)
#define PG8_SB(b, h) ((4 + (b) * 2 + (h)) * HTB)
#define PG8_STAGE(bufoff, gbase, voff) do { _Pragma("unroll") for (int _i = 0; _i < 2; ++_i) \
        __builtin_amdgcn_global_load_lds((const unsigned*)((const char*)(gbase) + (voff)[_i]), (PG8_LAS unsigned*)(lds + (bufoff) + ldsw + _i * 8192), 16, 0, 0); } while (0)
#define PG8_LDA(dst, b, h) do { _Pragma("unroll") for (int m = 0; m < 4; ++m) _Pragma("unroll") for (int k = 0; k < 2; ++k) dst[m][k] = *(const PG8_LAS bf16x8*)(lds + PG8_SA(b, h) + aoff + m * 2048 + k * 1024); } while (0)
#define PG8_LDB(dst, b, h) do { _Pragma("unroll") for (int n = 0; n < 2; ++n) _Pragma("unroll") for (int k = 0; k < 2; ++k) dst[n][k] = *(const PG8_LAS bf16x8*)(lds + PG8_SB(b, h) + boff + n * 2048 + k * 1024); } while (0)
#define PG8_MMA(ai, bj, At, Bt) do { __builtin_amdgcn_s_setprio(1); _Pragma("unroll") for (int m = 0; m < 4; ++m) _Pragma("unroll") for (int n = 0; n < 2; ++n) _Pragma("unroll") for (int k = 0; k < 2; ++k) \
        acc[ai][bj][m][n] = __builtin_amdgcn_mfma_f32_16x16x32_bf16(Bt[n][k], At[m][k], acc[ai][bj][m][n], 0, 0, 0); __builtin_amdgcn_s_setprio(0); } while (0)
#define PG8_WAIT_V(n) asm volatile("s_waitcnt vmcnt(" #n ")" ::: "memory")
#define PG8_WAIT_L(n) asm volatile("s_waitcnt lgkmcnt(" #n ")" ::: "memory")
#define PG8_BAR __builtin_amdgcn_s_barrier()
#define PG8_SCHED __builtin_amdgcn_sched_barrier(0)
    Unit cur, nxt; int ui = 0;
    if (!S.next(0, cur)) return;
    f32x4 acc[2][2][4][2];
#pragma unroll
    for (int a = 0; a < 2; ++a)
#pragma unroll
        for (int b = 0; b < 2; ++b)
#pragma unroll
            for (int m = 0; m < 4; ++m)
#pragma unroll
                for (int n = 0; n < 2; ++n) acc[a][b][m][n] = (f32x4){0.f, 0.f, 0.f, 0.f};
    bf16x8 At[4][2], B0[2][2], B1[2][2];
    const char* cA = (const char*)g.A + (size_t)cur.pm * tstep; const char* cB = (const char*)g.Bt + (size_t)cur.pn * tstep;
    S.a_ready(cur);
    if constexpr (SP2) {
        PG8_STAGE(PG8_SB(0, 0), cB, voffB); PG8_STAGE(PG8_SB(0, 1), cB + hstep, voffB); PG8_STAGE(PG8_SA(0, 0), cA, voffA); PG8_STAGE(PG8_SA(0, 1), cA + hstep, voffA);
        if (wr == 1) PG8_BAR;
        PG8_WAIT_V(2); PG8_BAR;
        PG8_STAGE(PG8_SB(1, 0), cB + kstep, voffB); PG8_STAGE(PG8_SA(1, 0), cA + kstep, voffA); PG8_STAGE(PG8_SB(1, 1), cB + hstep + kstep, voffB);
        PG8_WAIT_V(6); PG8_BAR;
    } else {
        PG8_STAGE(PG8_SB(0, 0), cB, voffB); PG8_STAGE(PG8_SA(0, 0), cA, voffA); PG8_STAGE(PG8_SB(0, 1), cB + hstep, voffB); PG8_STAGE(PG8_SA(0, 1), cA + hstep, voffA);
        if (wr == 1) PG8_BAR;
        PG8_WAIT_V(4); PG8_BAR;
        PG8_STAGE(PG8_SB(1, 0), cB + kstep, voffB); PG8_STAGE(PG8_SA(1, 0), cA + kstep, voffA); PG8_STAGE(PG8_SB(1, 1), cB + hstep + kstep, voffB);
        PG8_WAIT_V(6); PG8_BAR;
    }
    for (;;) {
        const bool has_next = S.next(ui + 1, nxt);
        const char* nA = has_next ? (const char*)g.A + (size_t)nxt.pm * tstep : cA; const char* nB = has_next ? (const char*)g.Bt + (size_t)nxt.pn * tstep : cB;
        for (int t = 0; t < nt; t += 2) {
            const bool last = (t == nt - 2);
            const char* a1 = cA + (size_t)(t + 1) * kstep;
            const char* a2 = last ? nA : cA + (size_t)(t + 2) * kstep; const char* b2 = last ? nB : cB + (size_t)(t + 2) * kstep;
            const char* a3 = a2 + kstep; const char* b3 = b2 + kstep;
            if (last && has_next) S.a_ready(nxt);
            if constexpr (SP2) {
            PG8_LDB(B0, 0, 0); PG8_LDB(B1, 0, 1); PG8_SCHED; PG8_LDA(At, 0, 0); PG8_STAGE(PG8_SA(1, 1), a1 + hstep, voffA);
            PG8_WAIT_V(8); PG8_WAIT_L(0); PG8_BAR; PG8_MMA(0, 0, At, B0); PG8_MMA(0, 1, At, B1); PG8_BAR; PG8_SCHED;
            PG8_LDA(At, 0, 1); PG8_STAGE(PG8_SB(0, 0), b2, voffB); PG8_STAGE(PG8_SB(0, 1), b2 + hstep, voffB); PG8_STAGE(PG8_SA(0, 0), a2, voffA);
            PG8_WAIT_V(8); PG8_WAIT_L(0); PG8_BAR; PG8_MMA(1, 0, At, B0); PG8_MMA(1, 1, At, B1); PG8_BAR; PG8_SCHED;
            PG8_LDB(B0, 1, 0); PG8_LDB(B1, 1, 1); PG8_SCHED; PG8_LDA(At, 1, 0); PG8_STAGE(PG8_SA(0, 1), a2 + hstep, voffA);
            PG8_WAIT_V(8); PG8_WAIT_L(0); PG8_BAR; PG8_MMA(0, 0, At, B0); PG8_MMA(0, 1, At, B1); PG8_BAR; PG8_SCHED;
            PG8_LDA(At, 1, 1); PG8_STAGE(PG8_SB(1, 0), b3, voffB); PG8_STAGE(PG8_SB(1, 1), b3 + hstep, voffB); PG8_STAGE(PG8_SA(1, 0), a3, voffA);
            PG8_WAIT_V(8); PG8_WAIT_L(0); PG8_BAR; PG8_MMA(1, 0, At, B0); PG8_MMA(1, 1, At, B1); PG8_BAR; PG8_SCHED;
            } else {
            PG8_LDB(B0, 0, 0); PG8_SCHED; PG8_LDA(At, 0, 0); PG8_STAGE(PG8_SA(1, 1), a1 + hstep, voffA);
            PG8_WAIT_L(8); PG8_BAR; PG8_WAIT_L(0); PG8_MMA(0, 0, At, B0); PG8_BAR; PG8_SCHED;
            PG8_LDB(B1, 0, 1); PG8_STAGE(PG8_SB(0, 0), b2, voffB);
            PG8_BAR; PG8_WAIT_L(0); PG8_MMA(0, 1, At, B1); PG8_BAR;
            PG8_LDA(At, 0, 1); PG8_STAGE(PG8_SA(0, 0), a2, voffA);
            PG8_BAR; PG8_WAIT_L(0); PG8_MMA(1, 0, At, B0); PG8_BAR; PG8_SCHED;
            PG8_STAGE(PG8_SB(0, 1), b2 + hstep, voffB);
            PG8_WAIT_V(6); PG8_BAR; PG8_MMA(1, 1, At, B1); PG8_BAR;
            PG8_LDB(B0, 1, 0); PG8_SCHED; PG8_LDA(At, 1, 0); PG8_STAGE(PG8_SA(0, 1), a2 + hstep, voffA);
            PG8_WAIT_L(8); PG8_BAR; PG8_WAIT_L(0); PG8_MMA(0, 0, At, B0); PG8_BAR; PG8_SCHED;
            PG8_LDB(B1, 1, 1); PG8_STAGE(PG8_SB(1, 0), b3, voffB);
            PG8_BAR; PG8_WAIT_L(0); PG8_MMA(0, 1, At, B1); PG8_BAR;
            PG8_LDA(At, 1, 1); PG8_STAGE(PG8_SA(1, 0), a3, voffA);
            PG8_BAR; PG8_WAIT_L(0); PG8_MMA(1, 0, At, B0); PG8_BAR; PG8_SCHED;
            PG8_STAGE(PG8_SB(1, 1), b3 + hstep, voffB);
            PG8_WAIT_V(6); PG8_BAR; PG8_MMA(1, 1, At, B1); PG8_BAR;
            }
        }
        if constexpr (ALIGN_EPI) { if (wr == 0) PG8_BAR; }
        if constexpr (!Epi::AFTER_DRAIN) { E(acc, cur, wr, wc, fr, fq); S.done(cur); }
        if (!has_next) break;
#pragma unroll
        for (int a = 0; a < 2; ++a)
#pragma unroll
            for (int b = 0; b < 2; ++b)
#pragma unroll
                for (int m = 0; m < 4; ++m)
#pragma unroll
                    for (int n = 0; n < 2; ++n) acc[a][b][m][n] = (f32x4){0.f, 0.f, 0.f, 0.f};
        cur = nxt; cA = nA; cB = nB; ++ui;
        if constexpr (ALIGN_EPI) { if (wr == 1) PG8_BAR; }
    }
    PG8_WAIT_V(0);
    if constexpr (!ALIGN_EPI) { if (wr == 0) PG8_BAR; }
    PG8_BAR;
    if constexpr (Epi::AFTER_DRAIN) { E.fused(acc, cur, wr, wc, fr, fq, lds, wid, lane); S.done(cur); }
#undef PG8_SA
#undef PG8_SB
#undef PG8_STAGE
#undef PG8_LDA
#undef PG8_LDB
#undef PG8_MMA
#undef PG8_WAIT_V
#undef PG8_WAIT_L
#undef PG8_BAR
#undef PG8_SCHED
}
}
constexpr int NWAVES = 8, NTHR = 512;
constexpr int BATCH = 8, S = 2048, D = 1024, M = BATCH * S;
constexpr int NSA_NP = 5888, RET_NP = 6144;
constexpr int NCMP = 127;
constexpr float RMS_EPS = 1e-6f, GN_EPS = 1e-6f;
constexpr size_t MiB = 1u << 20;
constexpr size_t WS_CTL = 0, CTL_ZERO_BYTES = 1 * MiB;
constexpr size_t WS_COS = 1 * MiB, WS_SIN = 2 * MiB;
constexpr size_t WS_WIN = 4 * MiB;
constexpr size_t WS_WOUT = 16 * MiB;
constexpr size_t WS_HB = 24 * MiB;
constexpr size_t WS_ACT = 56 * MiB;
constexpr size_t NSA_Q = WS_ACT, NSA_KV = WS_ACT + 32 * MiB, NSA_Z = WS_ACT + 80 * MiB, NSA_GT = WS_ACT + 176 * MiB, NSA_KC = WS_ACT + 179 * MiB, NSA_VC = WS_ACT + 180 * MiB;
constexpr size_t NSA_YO = NSA_Z;
constexpr size_t RET_Q = WS_ACT, RET_K = WS_ACT + 32 * MiB, RET_V = WS_ACT + 64 * MiB, RET_Z = WS_ACT + 128 * MiB;
constexpr size_t RET_YO = RET_Q;
constexpr size_t WS_END = WS_ACT + 192 * MiB;
static_assert(WS_END <= 256 * MiB, "d_ws map");
constexpr int CW_TMO = 0, CW_CODE = 1;
constexpr int CW_BAR = 4096;
constexpr int CW_RSS = 16384;
static_assert((CW_RSS + 5 * 16384) * 4 <= (int)CTL_ZERO_BYTES, "CTL words inside the memset region");
constexpr int RING_OFF = 0, RING_BYTES = 139264;
constexpr int LDSCTL_OFF = RING_BYTES, MISC_OFF = LDSCTL_OFF + 320;
constexpr int LDS_BYTES = 147456;
#define GAS __attribute__((address_space(1)))
#define LAS __attribute__((address_space(3)))
typedef unsigned short bf16;
typedef unsigned v4u __attribute__((ext_vector_type(4)));
typedef unsigned v2u __attribute__((ext_vector_type(2)));
typedef float f32x4 __attribute__((ext_vector_type(4)));
typedef GAS unsigned gu32;
#define RLX_AGENT __ATOMIC_RELAXED, __HIP_MEMORY_SCOPE_AGENT
#define LDS_WAIT() asm volatile("s_waitcnt lgkmcnt(0)" ::: "memory")
#define VM_WAIT() asm volatile("s_waitcnt vmcnt(0)" ::: "memory")
__device__ __forceinline__ unsigned f2bf(float f) { unsigned u = __builtin_bit_cast(unsigned, f); return (u + 0x7fffu + ((u >> 16) & 1u)) >> 16; }
__device__ __forceinline__ unsigned pk2(float lo, float hi) { return f2bf(lo) | (f2bf(hi) << 16); }
__device__ __forceinline__ float bf2f(unsigned short b) { return __builtin_bit_cast(float, (unsigned)b << 16); }
__device__ __forceinline__ float bflo(unsigned w) { return __builtin_bit_cast(float, w << 16); }
__device__ __forceinline__ float bfhi(unsigned w) { return __builtin_bit_cast(float, w & 0xffff0000u); }
__device__ __forceinline__ float wave_sum(float v) {
#pragma unroll
    for (int o = 1; o < 64; o <<= 1) v += __shfl_xor(v, o);
    return v;
}
__device__ __forceinline__ float wave_max(float v) {
#pragma unroll
    for (int o = 1; o < 64; o <<= 1) v = fmaxf(v, __shfl_xor(v, o));
    return v;
}
#define XB_TMO      128
#define XB_XCNT(j)  (256  + 64 * (j))
#define XB_XSUB(j)  (1280 + 64 * (j))
#define XB_XGEN(j)  (2304 + 64 * (j))
#define XB_TOP      3328
#define XB_TOPGEN   3392
#define XCD_BAR_WORDS 3456
#define XB_SPIN_CAP (1u << 18)

__device__ __forceinline__ unsigned xb_ld(unsigned* p)              { return __hip_atomic_load(p, __ATOMIC_RELAXED, __HIP_MEMORY_SCOPE_AGENT); }
__device__ __forceinline__ unsigned xb_add(unsigned* p, unsigned v) { return __hip_atomic_fetch_add(p, v, __ATOMIC_RELAXED, __HIP_MEMORY_SCOPE_AGENT); }
__device__ __forceinline__ unsigned xb_xcc_id() { return (unsigned)__builtin_amdgcn_s_getreg((3 << 11) | 20) & 0xFu; }
#define XB_SPIN(cond, bar) do { unsigned _sp = 0; while (cond) { __builtin_amdgcn_s_sleep(1); \
    if ((++_sp & 255u) == 0u) { if (xb_ld(&(bar)[XB_TMO])) break; if (_sp > XB_SPIN_CAP) { atomicAdd(&(bar)[XB_TMO], 1u); break; } } } } while (0)

struct XcdBarrier {
    unsigned* bar; unsigned x;
    volatile LAS unsigned* st;
};

__device__ __forceinline__ XcdBarrier xcd_barrier_post(unsigned* bar, volatile LAS unsigned* st) {
    XcdBarrier b; b.bar = bar; b.x = xb_xcc_id(); b.st = st;
    if (threadIdx.x == 0) (void)xb_add(&bar[XB_XCNT(b.x)], 1u);
    return b;
}
__device__ __forceinline__ void xcd_barrier_complete(unsigned* bar, unsigned x, unsigned& nloc, unsigned& nx) {
    const unsigned G = gridDim.x * gridDim.y * gridDim.z;
    unsigned sum, cnt, mine, sp = 0u;
    for (;;) {
        sum = 0u; cnt = 0u; mine = 0u;
#pragma unroll
        for (unsigned j = 0; j < 16; ++j) { const unsigned c = xb_ld(&bar[XB_XCNT(j)]); sum += c; cnt += (c > 0u) ? 1u : 0u; mine = (j == x) ? c : mine; }
        if (sum == G) break;
        __builtin_amdgcn_s_sleep(1);
        if ((++sp & 255u) == 0u) { if (xb_ld(&bar[XB_TMO])) break; if (sp > XB_SPIN_CAP) { atomicAdd(&bar[XB_TMO], 1u); break; } }
    }
    nloc = mine > 0u ? mine : 1u; nx = cnt > 0u ? cnt : 1u;
}

__device__ __forceinline__ void xcd_barrier(const XcdBarrier& b) {
    asm volatile("s_waitcnt vmcnt(0)" ::: "memory");
    __syncthreads();
    if (threadIdx.x == 0) {
        unsigned* bar = b.bar;
        __builtin_amdgcn_s_waitcnt(0);
        unsigned nloc = b.st[0], nx = b.st[1];
        if (nloc == 0u) { xcd_barrier_complete(bar, b.x, nloc, nx); b.st[0] = nloc; b.st[1] = nx; }
        const unsigned old = xb_add(&bar[XB_XSUB(b.x)], 1u);
        const unsigned gen = old / nloc;
        if (old + 1u == (gen + 1u) * nloc) {
            __builtin_amdgcn_fence(__ATOMIC_RELEASE, "agent");
            asm volatile("s_waitcnt vmcnt(0)" ::: "memory");
            const unsigned og = xb_add(&bar[XB_TOP], 1u);
            const unsigned tg = og / nx;
            if (og + 1u == (tg + 1u) * nx) xb_add(&bar[XB_TOPGEN], 1u);
            else XB_SPIN(xb_ld(&bar[XB_TOPGEN]) == tg, bar);
            __builtin_amdgcn_fence(__ATOMIC_ACQUIRE, "agent");
            xb_add(&bar[XB_XGEN(b.x)], 1u);
            asm volatile("s_waitcnt vmcnt(0)" ::: "memory");
        } else {
            XB_SPIN(xb_ld(&bar[XB_XGEN(b.x)]) == gen, bar);
            __builtin_amdgcn_fence(__ATOMIC_ACQUIRE, "agent");
            asm volatile("s_waitcnt vmcnt(0)" ::: "memory");
        }
    }
    __syncthreads();
}

struct Ctx { LAS unsigned char* lds; int tid, lane, wave, vcu, G; const float* in[15]; float* out; unsigned char* ws; };
enum { IN_X = 0, IN_PRE, IN_POST, IN_TAB, IN_NWIN, IN_NWOUT, IN_KPOS, IN_KW1, IN_KW2, IN_VPOS, IN_VW1, IN_VW2, IN_RWIN, IN_RWOUT, IN_GN };

__device__ __forceinline__ int t5_bucket(int d) { int r = 16 + (int)((16.0f / 3.0f) * (__log2f((float)(d < 1 ? 1 : d)) - 4.0f)); r = r > 31 ? 31 : r; return d < 16 ? d : r; }

__device__ __forceinline__ int nsa_src_col(int n) { return n < 2560 ? n : (n < 5632 ? n + 48 : (n < 5680 ? n - 3072 : -1)); }
template <int MODE> __device__ __forceinline__ void convert_item(const float* W, int K, int Nsrc, const float* gain, bf16* WT, LAS float* scr, int item, int nblk, int lane) {
    const int kb = item / nblk, nb = item % nblk, k0 = 64 * kb, n0 = 32 * nb;
    const int n = n0 + (lane & 31), sc = MODE == 1 ? nsa_src_col(n) : n;
#pragma unroll 8
    for (int i = 0; i < 32; ++i) { const int kk = 2 * i + (lane >> 5); float v = 0.f;
        if (sc >= 0) { v = W[(size_t)(k0 + kk) * Nsrc + sc]; if (gain) v *= gain[k0 + kk]; }
        scr[kk * 33 + (lane & 31)] = v; }
    LDS_WAIT();
    const int c = lane & 7;
#pragma unroll
    for (int j = 0; j < 4; ++j) { const int nn = (lane >> 3) + 8 * j; const LAS float* s = scr + (8 * c) * 33 + nn;
        v4u o; o.x = pk2(s[0 * 33], s[1 * 33]); o.y = pk2(s[2 * 33], s[3 * 33]); o.z = pk2(s[4 * 33], s[5 * 33]); o.w = pk2(s[6 * 33], s[7 * 33]);
        *(v4u*)(WT + (size_t)(n0 + nn) * K + k0 + 8 * c) = o; }
    LDS_WAIT();
}
template <int MODE> __device__ __forceinline__ void convert_weights(const Ctx& C, const float* W, int K, int Nsrc, int Ndst, const float* gain, bf16* WT) {
    LAS float* scr = (LAS float*)(C.lds + C.wave * 16384);
    const int gw = C.vcu * NWAVES + C.wave, NGW = C.G * NWAVES, nblk = Ndst / 32, nitems = (K / 64) * nblk;
    for (int it = gw; it < nitems; it += NGW) convert_item<MODE>(W, K, Nsrc, gain, WT, scr, it, nblk, C.lane);
}

__device__ __forceinline__ void p0_rows(const Ctx& C) {
    const int gw = C.vcu * NWAVES + C.wave, NGW = C.G * NWAVES;
    bf16* HB = (bf16*)(C.ws + WS_HB); float* rss = (float*)(C.ws + WS_CTL) + CW_RSS;
    for (int m = gw; m < M; m += NGW) {
        const f32x4* xr = (const f32x4*)(C.in[IN_X] + (size_t)m * D) + C.lane; f32x4 v[4]; float s = 0.f;
#pragma unroll
        for (int j = 0; j < 4; ++j) { v[j] = xr[64 * j]; s += (v[j].x * v[j].x + v[j].y * v[j].y) + (v[j].z * v[j].z + v[j].w * v[j].w); }
        s = wave_sum(s);
        unsigned long long* o8 = (unsigned long long*)(HB + (size_t)m * D) + C.lane;
#pragma unroll
        for (int j = 0; j < 4; ++j) o8[64 * j] = (unsigned long long)pk2(v[j].x, v[j].y) | ((unsigned long long)pk2(v[j].z, v[j].w) << 32);
        if (C.lane == 0) rss[m] = s;
    }
}
__device__ __forceinline__ void p0_tables(const Ctx& C) {
    float* COS = (float*)(C.ws + WS_COS); float* SIN = (float*)(C.ws + WS_SIN);
    for (int idx = C.vcu * NTHR + C.tid; idx < S * 128; idx += C.G * NTHR) {
        const int s = idx >> 7, i = idx & 127;
        const float inv = (float)(1.0 / exp2((double)i * (13.287712379549449 / 127.0)));
        const float ang = (float)s * inv;
        double rev = (double)ang * 0.15915494309189535; rev -= floor(rev + 0.5);
        const float rf = (float)rev;
        COS[idx] = __builtin_amdgcn_cosf(rf); SIN[idx] = __builtin_amdgcn_sinf(rf);
    }
}

__device__ __forceinline__ void naive_compress(const Ctx& C, int slot) {
    LAS float* xs = (LAS float*)(C.lds);
    LAS float* hid = (LAS float*)(C.lds + 32768);
    const bf16* KV = (const bf16*)(C.ws + NSA_KV);
    if (C.vcu == 0) for (int i = C.tid; i < 2 * 32 * 64; i += NTHR) { const int kv = i >> 11, bg = (i >> 6) & 31, d = i & 63;
        ((bf16*)(C.ws + (kv ? NSA_VC : NSA_KC)))[((size_t)bg * 128 + 127) * 64 + d] = 0; }
    for (int unit = C.vcu; unit < 2 * BATCH * NCMP; unit += C.G) {
        const int kv = unit / (BATCH * NCMP), rem = unit % (BATCH * NCMP), b = rem / NCMP, c = rem % NCMP;
        const float* pos = C.in[kv ? IN_VPOS : IN_KPOS] + (size_t)slot * 2048;
        const float* w1 = C.in[kv ? IN_VW1 : IN_KW1] + (size_t)slot * 2048 * 256;
        const float* w2 = C.in[kv ? IN_VW2 : IN_KW2] + (size_t)slot * 256 * 64;
        const bf16* src = KV + (size_t)kv * (16384 * 256);
        bf16* dst = (bf16*)(C.ws + (kv ? NSA_VC : NSA_KC));
        for (int idx = C.tid; idx < 8192; idx += NTHR) { const int g = idx >> 11, k = idx & 2047;
            xs[idx] = bf2f(src[((size_t)((b * 4 + g) * 2048 + 16 * c)) * 64 + k]) + pos[k]; }
        __syncthreads();
        { const int j = C.tid & 255, hf = C.tid >> 8; float a0 = 0.f, a1 = 0.f;
          const LAS float* x0 = xs + (2 * hf) * 2048; const LAS float* x1 = x0 + 2048;
#pragma unroll 4
          for (int k = 0; k < 2048; ++k) { const float w = w1[(size_t)k * 256 + j]; a0 += x0[k] * w; a1 += x1[k] * w; }
          hid[(2 * hf) * 256 + j] = a0 / (1.0f + __expf(-a0)); hid[(2 * hf + 1) * 256 + j] = a1 / (1.0f + __expf(-a1)); }
        __syncthreads();
        if (C.tid < 256) { const int g = C.tid >> 6, d = C.tid & 63; float a = 0.f;
#pragma unroll 4
            for (int j = 0; j < 256; ++j) a += hid[g * 256 + j] * w2[j * 64 + d];
            dst[((size_t)((b * 4 + g) * 128 + c)) * 64 + d] = (bf16)f2bf(a); }
        __syncthreads();
    }
}

__device__ __forceinline__ float dot64(const LAS float* q, const bf16* krow) {
    const v4u* kp = (const v4u*)krow; float s = 0.f;
#pragma unroll
    for (int c = 0; c < 8; ++c) { const v4u w = kp[c]; const LAS float* qq = q + c * 8;
        s += qq[0] * bflo(w.x) + qq[1] * bfhi(w.x) + qq[2] * bflo(w.y) + qq[3] * bfhi(w.y) + qq[4] * bflo(w.z) + qq[5] * bfhi(w.z) + qq[6] * bflo(w.w) + qq[7] * bfhi(w.w); }
    return s;
}
struct SoftAcc { float m, l, o; };
__device__ __forceinline__ void attn_block(SoftAcc& a, const LAS float* q, LAS float* pw, const bf16* Kblk, const bf16* Vblk, float bias, bool valid, int lane) {
    const float lg = valid ? dot64(q, Kblk + lane * 64) * 0.125f + bias : -1e30f;
    const float bm = wave_max(lg);
    if (bm <= -1e29f) return;
    const float mn = fmaxf(a.m, bm), sc = __expf(a.m - mn), p = valid ? __expf(lg - mn) : 0.f;
    a.l = a.l * sc + wave_sum(p); a.o *= sc; a.m = mn;
    pw[lane] = p; LDS_WAIT();
    float o = a.o;
#pragma unroll 8
    for (int k = 0; k < 64; ++k) o += pw[k] * bf2f(Vblk[k * 64 + lane]);
    a.o = o; LDS_WAIT();
}
__device__ __forceinline__ void naive_nsa_attn(const Ctx& C) {
    LAS float* lut = (LAS float*)(C.lds);
    LAS float* qs = (LAS float*)(C.lds + 8448);
    LAS float* pc = (LAS float*)(C.lds + 10496);
    LAS float* pwA = (LAS float*)(C.lds + 14592);
    const float* tab = C.in[IN_TAB];
    for (int i = C.tid; i < 16 * 129; i += NTHR) { const int h = i / 129, d = i % 129; lut[i] = tab[t5_bucket(d) * 16 + h]; }
    __syncthreads();
    bf16* Q = (bf16*)(C.ws + NSA_Q); const bf16* KV = (const bf16*)(C.ws + NSA_KV); const bf16* Z = (const bf16*)(C.ws + NSA_Z); const float* GT = (const float*)(C.ws + NSA_GT);
    const bf16* KC = (const bf16*)(C.ws + NSA_KC); const bf16* VC = (const bf16*)(C.ws + NSA_VC);
    const int w = C.wave, lane = C.lane;
    LAS float* q = qs + w * 64; LAS float* pw = pwA + w * 64; LAS float* pcw = pc + w * 128;
    for (int unit = C.vcu; unit < BATCH * S * 2; unit += C.G) {
        const int b = unit >> 12, rem = unit & 4095, t = rem >> 1, gp = rem & 1, g = gp * 2 + (w >> 2), h = g * 4 + (w & 3);
        const int row = b * S + t;
        const LAS float* lh = lut + h * 129;
        q[lane] = bf2f(Q[(size_t)row * 1024 + h * 64 + lane]); LDS_WAIT();
        const size_t gofs = (size_t)(b * 4 + g);
        float o_cmp;
        { const bf16* KCb = KC + gofs * 128 * 64; const bf16* VCb = VC + gofs * 128 * 64;
          const int e0 = 16 * lane + 31, e1 = 16 * (64 + lane) + 31; const bool v0 = e0 <= t, v1 = (lane < 63) && (e1 <= t);
          const int d0 = t - e0, d1 = t - e1;
          const float lg0 = v0 ? dot64(q, KCb + lane * 64) * 0.125f + lh[d0 > 128 ? 128 : (d0 < 0 ? 0 : d0)] : -1e30f;
          const float lg1 = v1 ? dot64(q, KCb + (64 + lane) * 64) * 0.125f + lh[d1 > 128 ? 128 : (d1 < 0 ? 0 : d1)] : -1e30f;
          const float mx = wave_max(fmaxf(lg0, lg1));
          float p0 = v0 ? __expf(lg0 - mx) : 0.f, p1 = v1 ? __expf(lg1 - mx) : 0.f;
          const float l = wave_sum(p0 + p1), inv = l > 0.f ? 1.0f / l : 0.f;
          p0 *= inv; p1 *= inv; pcw[lane] = p0; pcw[64 + lane] = p1; LDS_WAIT();
          float o = 0.f;
#pragma unroll 8
          for (int c = 0; c < NCMP; ++c) o += pcw[c] * bf2f(VCb[c * 64 + lane]);
          o_cmp = o; }
        __syncthreads();
        unsigned selmask;
        { const int j = lane & 31, cur = t >> 6; float imp = 0.f; const LAS float* pg = pc + (w & 4) * 128;
          const int clo = 4 * j - 1 < 0 ? 0 : 4 * j - 1, chi = 4 * j + 3 > 126 ? 126 : 4 * j + 3;
          for (int r = 0; r < 4; ++r) for (int c = clo; c <= chi; ++c) imp += pg[r * 128 + c];
          const bool valid = j <= cur, forced = (j == 0) || (j == cur) || (j == cur - 1);
          const float score = valid ? imp + (forced ? 1000.0f : 0.f) : -1e30f;
          int rank = 0;
          for (int i = 0; i < 32; ++i) { const float si = __shfl(score, i); rank += ((si > score) || (si == score && i < j)) ? 1 : 0; }
          selmask = (unsigned)(__ballot(rank < 16) & 0xffffffffull); }
        __syncthreads();
        const int cur = t >> 6;
        SoftAcc as{-1e30f, 0.f, 0.f};
        { const bf16* Kb = KV + (size_t)2 * (16384 * 256) + gofs * 2048 * 64; const bf16* Vb = KV + (size_t)3 * (16384 * 256) + gofs * 2048 * 64;
          for (int j = 0; j <= cur; ++j) if ((selmask >> j) & 1u) { const int pos = 64 * j + lane, dist = t - pos;
              attn_block(as, q, pw, Kb + (size_t)j * 4096, Vb + (size_t)j * 4096, lh[dist > 128 ? 128 : (dist < 0 ? 0 : dist)], dist >= 0, lane); } }
        SoftAcc aw{-1e30f, 0.f, 0.f};
        { const bf16* Kb = KV + (size_t)4 * (16384 * 256) + gofs * 2048 * 64; const bf16* Vb = KV + (size_t)5 * (16384 * 256) + gofs * 2048 * 64;
          const int jlo = (t - 511 < 0 ? 0 : t - 511) >> 6;
          for (int j = jlo; j <= cur; ++j) { const int pos = 64 * j + lane, dist = t - pos;
              attn_block(aw, q, pw, Kb + (size_t)j * 4096, Vb + (size_t)j * 4096, lh[dist > 128 ? 128 : (dist < 0 ? 0 : dist)], dist >= 0 && dist < 512, lane); } }
        const float o_slc = as.l > 0.f ? as.o / as.l : 0.f, o_win = aw.l > 0.f ? aw.o / aw.l : 0.f;
        const float* gt = GT + (size_t)row * 48; const bf16* zr = Z + (size_t)row * 3072 + h * 64 + lane;
        const float y = gt[h] * o_cmp * bf2f(zr[0]) + gt[16 + h] * o_slc * bf2f(zr[1024]) + gt[32 + h] * o_win * bf2f(zr[2048]);
        Q[(size_t)row * 1024 + h * 64 + lane] = (bf16)f2bf(y);
    }
}

__device__ __forceinline__ void naive_retention(const Ctx& C, int slot) {
    LAS float* qs = (LAS float*)(C.lds);
    LAS float* as = (LAS float*)(C.lds + 8192);
    LAS float* red = (LAS float*)(C.lds + 8192 + 65536);
    const bf16* Qr = (const bf16*)(C.ws + RET_Q); const bf16* Kr = (const bf16*)(C.ws + RET_K); const bf16* Vr = (const bf16*)(C.ws + RET_V); bf16* Zr = (bf16*)(C.ws + RET_Z);
    const float* gn = C.in[IN_GN] + (size_t)slot * 2048;
    const int tid = C.tid, lane = C.lane, w = C.wave;
    for (int unit = C.vcu; unit < BATCH * 4 * 256; unit += C.G) {
        const int b = unit >> 10, h = (unit >> 8) & 3, t0 = (unit & 255) * 8, tmax = t0 + 7;
        for (int idx = tid; idx < 2048; idx += NTHR) { const int i = idx >> 8, d = idx & 255; qs[idx] = bf2f(Qr[(size_t)(b * S + t0 + i) * 1024 + h * 256 + d]); }
        __syncthreads();
        const float lg = __log2f(1.0f - exp2f(-5.0f - (float)h));
        for (int s = tid; s <= tmax; s += NTHR) {
            const v4u* kp = (const v4u*)(Kr + (size_t)(b * S + s) * 1024 + h * 256);
            float acc[8];
#pragma unroll
            for (int i = 0; i < 8; ++i) acc[i] = 0.f;
#pragma unroll 2
            for (int c = 0; c < 32; ++c) { const v4u kw = kp[c];
                const float k0 = bflo(kw.x), k1 = bfhi(kw.x), k2 = bflo(kw.y), k3 = bfhi(kw.y), k4 = bflo(kw.z), k5 = bfhi(kw.z), k6 = bflo(kw.w), k7 = bfhi(kw.w);
#pragma unroll
                for (int i = 0; i < 8; ++i) { const LAS float* qq = qs + i * 256 + c * 8;
                    acc[i] += qq[0] * k0 + qq[1] * k1 + qq[2] * k2 + qq[3] * k3 + qq[4] * k4 + qq[5] * k5 + qq[6] * k6 + qq[7] * k7; } }
#pragma unroll
            for (int i = 0; i < 8; ++i) { const int dist = t0 + i - s; as[i * 2048 + s] = dist >= 0 ? acc[i] * exp2f((float)dist * lg) : 0.f; }
        }
        __syncthreads();
        float o[8];
#pragma unroll
        for (int i = 0; i < 8; ++i) o[i] = 0.f;
        { const bf16* vp = Vr + (size_t)(b * S) * 2048 + h * 512 + tid;
#pragma unroll 4
          for (int s = 0; s <= tmax; ++s) { const float vv = bf2f(vp[(size_t)s * 2048]);
#pragma unroll
              for (int i = 0; i < 8; ++i) o[i] += as[i * 2048 + s] * vv; } }
        float mu[8];
#pragma unroll
        for (int i = 0; i < 8; ++i) { const float sm = wave_sum(o[i]); if (lane == 0) red[w * 8 + i] = sm; }
        __syncthreads();
#pragma unroll
        for (int i = 0; i < 8; ++i) { float sm = 0.f;
#pragma unroll
            for (int ww = 0; ww < 8; ++ww) sm += red[ww * 8 + i];
            mu[i] = sm * (1.0f / 512.0f); }
        __syncthreads();
#pragma unroll
        for (int i = 0; i < 8; ++i) { const float d = o[i] - mu[i]; const float sq = wave_sum(d * d); if (lane == 0) red[w * 8 + i] = sq; }
        __syncthreads();
#pragma unroll
        for (int i = 0; i < 8; ++i) { float sq = 0.f;
#pragma unroll
            for (int ww = 0; ww < 8; ++ww) sq += red[ww * 8 + i];
            const float rstd = rsqrtf(sq * (1.0f / 512.0f) + GN_EPS);
            const size_t idx = (size_t)(b * S + t0 + i) * 2048 + h * 512 + tid;
            Zr[idx] = (bf16)f2bf((o[i] - mu[i]) * rstd * gn[h * 512 + tid] * bf2f(Zr[idx])); }
        __syncthreads();
    }
}

__device__ __forceinline__ void naive_norm_res(const Ctx& C, int layer, const float* YO) {
    const int gw = C.vcu * NWAVES + C.wave, NGW = C.G * NWAVES;
    bf16* HB = (bf16*)(C.ws + WS_HB); float* rss = (float*)(C.ws + WS_CTL) + CW_RSS + (size_t)(layer + 1) * 16384;
    const float* hp = layer == 0 ? C.in[IN_X] : C.out; const float* gain = C.in[IN_POST] + (size_t)layer * D;
    for (int m = gw; m < M; m += NGW) {
        const f32x4* yr = (const f32x4*)(YO + (size_t)m * D) + C.lane; f32x4 v[4]; float s = 0.f;
#pragma unroll
        for (int j = 0; j < 4; ++j) { v[j] = yr[64 * j]; s += (v[j].x * v[j].x + v[j].y * v[j].y) + (v[j].z * v[j].z + v[j].w * v[j].w); }
        const float rstd = rsqrtf(wave_sum(s) * (1.0f / 1024.0f) + RMS_EPS);
        const f32x4* hr = (const f32x4*)(hp + (size_t)m * D) + C.lane; const f32x4* gr = (const f32x4*)gain + C.lane;
        f32x4* orow = (f32x4*)(C.out + (size_t)m * D) + C.lane;
        unsigned long long* o8 = (unsigned long long*)(HB + (size_t)m * D) + C.lane; float s2 = 0.f;
#pragma unroll
        for (int j = 0; j < 4; ++j) { const f32x4 hn = hr[64 * j] + v[j] * rstd * gr[64 * j]; orow[64 * j] = hn;
            s2 += (hn.x * hn.x + hn.y * hn.y) + (hn.z * hn.z + hn.w * hn.w);
            o8[64 * j] = (unsigned long long)pk2(hn.x, hn.y) | ((unsigned long long)pk2(hn.z, hn.w) << 32); }
        s2 = wave_sum(s2);
        if (C.lane == 0) rss[m] = s2;
    }
}
namespace nsa {
typedef short bf16x8 __attribute__((ext_vector_type(8)));
typedef short s16x4 __attribute__((ext_vector_type(4)));
typedef float f32x16 __attribute__((ext_vector_type(16)));
constexpr int KB0 = 0, VB0 = 8192, LUT_OFF = 32768, GE_OFF = 49152, SC_OFF = 114688, SELM_OFF = 116736;
constexpr float LOG2E = 1.4426950408889634f, SC2 = 0.125f * 1.4426950408889634f;
constexpr size_t TS = (size_t)16384 * 256;
typedef float f32x2_t __attribute__((ext_vector_type(2))); typedef __bf16 bf16x2_t __attribute__((ext_vector_type(2)));
__device__ __forceinline__ unsigned cvtpk(float lo, float hi) { f32x2_t v = {lo, hi}; bf16x2_t b = __builtin_convertvector(v, bf16x2_t); return __builtin_bit_cast(unsigned, b); }
__device__ __forceinline__ s16x4 vtr(const LAS unsigned char* p) { typedef short v4i16_t __attribute__((ext_vector_type(4))); return __builtin_bit_cast(s16x4, __builtin_amdgcn_ds_read_tr16_b64_v4i16((LAS v4i16_t*)p)); }
__device__ __forceinline__ float xhalf_max(float m) { auto rr = __builtin_amdgcn_permlane32_swap(__float_as_uint(m), __float_as_uint(m), false, false); return fmaxf(__uint_as_float(rr[0]), __uint_as_float(rr[1])); }
__device__ __forceinline__ float xhalf_sum(float m) { auto rr = __builtin_amdgcn_permlane32_swap(__float_as_uint(m), __float_as_uint(m), false, false); return __uint_as_float(rr[0]) + __uint_as_float(rr[1]); }
__device__ __forceinline__ int koff(int i) { return (i & 3) + 8 * (i >> 2); }

struct Soft { float m, l; f32x16 o0, o1; };

__device__ __forceinline__ void attn_tile(Soft& st, const LAS unsigned char* Kb, const LAS unsigned char* Vb, const bf16x8 (&qf)[4], const unsigned (&kof)[4], unsigned vof0, unsigned vof1,
                                          int kind, int base_d, bool sel, const LAS float* lutp, float lut128, LAS float* ge, int gj0, float& alpha_out) {
    f32x16 s0, s1;
#pragma unroll
    for (int i = 0; i < 16; ++i) { s0[i] = 0.f; s1[i] = 0.f; }
#pragma unroll
    for (int ks = 0; ks < 4; ++ks) {
        const bf16x8 a0 = *(const LAS bf16x8*)(Kb + kof[ks]), a1 = *(const LAS bf16x8*)(Kb + kof[ks] + 4096);
        s0 = __builtin_amdgcn_mfma_f32_32x32x16_bf16(a0, qf[ks], s0, 0, 0, 0);
        s1 = __builtin_amdgcn_mfma_f32_32x32x16_bf16(a1, qf[ks], s1, 0, 0, 0);
    }
    const float NEG = -INFINITY;
    if (kind == 0) {
#pragma unroll
        for (int i = 0; i < 16; ++i) { const int d0 = base_d - 16 * koff(i), d1 = d0 - 512;
            const float b0 = lutp[d0 > 128 ? 128 : (d0 < 0 ? 0 : d0)], b1 = lutp[d1 > 128 ? 128 : (d1 < 0 ? 0 : d1)];
            s0[i] = d0 >= 0 ? s0[i] * SC2 + b0 : NEG; s1[i] = d1 >= 0 ? s1[i] * SC2 + b1 : NEG; }
    } else if (kind == 1) {
#pragma unroll
        for (int i = 0; i < 16; ++i) { const int d0 = base_d - koff(i), d1 = d0 - 32;
            const float b0 = lutp[d0 > 128 ? 128 : (d0 < 0 ? 0 : d0)], b1 = lutp[d1 > 128 ? 128 : (d1 < 0 ? 0 : d1)];
            s0[i] = (d0 >= 0 && sel) ? s0[i] * SC2 + b0 : NEG; s1[i] = (d1 >= 0 && sel) ? s1[i] * SC2 + b1 : NEG; }
    } else if (kind == 2) {
        const float cb = sel ? lut128 : NEG;
#pragma unroll
        for (int i = 0; i < 16; ++i) { s0[i] = s0[i] * SC2 + cb; s1[i] = s1[i] * SC2 + cb; }
    } else {
#pragma unroll
        for (int i = 0; i < 16; ++i) { const int d0 = base_d - koff(i), d1 = d0 - 32;
            s0[i] = d0 < 512 ? s0[i] * SC2 + lut128 : NEG; s1[i] = d1 < 512 ? s1[i] * SC2 + lut128 : NEG; }
    }
    float bm = fmaxf(s0[0], s1[0]);
#pragma unroll
    for (int i = 1; i < 16; ++i) bm = fmaxf(bm, fmaxf(s0[i], s1[i]));
    bm = xhalf_max(bm);
    const float mn = fmaxf(st.m, bm), alpha = __builtin_amdgcn_exp2f(st.m - mn);
    st.m = mn; alpha_out = alpha;
    float ps = 0.f;
#pragma unroll
    for (int i = 0; i < 16; ++i) { s0[i] = __builtin_amdgcn_exp2f(s0[i] - mn); s1[i] = __builtin_amdgcn_exp2f(s1[i] - mn); ps += s0[i] + s1[i]; }
    st.l = st.l * alpha + ps;
#pragma unroll
    for (int i = 0; i < 16; ++i) { st.o0[i] *= alpha; st.o1[i] *= alpha; }
    if (ge) {
#pragma unroll
        for (int m4 = 0; m4 < 4; ++m4) {
            ge[gj0 + 2 * m4] = (s0[4 * m4] + s0[4 * m4 + 1]) + (s0[4 * m4 + 2] + s0[4 * m4 + 3]); ge[8192 + gj0 + 2 * m4] = s0[4 * m4 + 3];
            ge[gj0 + 8 + 2 * m4] = (s1[4 * m4] + s1[4 * m4 + 1]) + (s1[4 * m4 + 2] + s1[4 * m4 + 3]); ge[8192 + gj0 + 8 + 2 * m4] = s1[4 * m4 + 3]; }
    }
    bf16x8 pf[4];
#pragma unroll
    for (int sp = 0; sp < 4; ++sp) {
        v4u w;
        if (sp < 2) { w.x = cvtpk(s0[8 * sp], s0[8 * sp + 1]); w.y = cvtpk(s0[8 * sp + 2], s0[8 * sp + 3]); w.z = cvtpk(s0[8 * sp + 4], s0[8 * sp + 5]); w.w = cvtpk(s0[8 * sp + 6], s0[8 * sp + 7]); }
        else { const int q = sp - 2; w.x = cvtpk(s1[8 * q], s1[8 * q + 1]); w.y = cvtpk(s1[8 * q + 2], s1[8 * q + 3]); w.z = cvtpk(s1[8 * q + 4], s1[8 * q + 5]); w.w = cvtpk(s1[8 * q + 6], s1[8 * q + 7]); }
        pf[sp] = __builtin_bit_cast(bf16x8, w);
    }
#pragma unroll
    for (int sp = 0; sp < 4; ++sp) {
        const s16x4 l0 = vtr(Vb + vof0 + 2048 * sp), h0 = vtr(Vb + vof0 + 2048 * sp + 1024), l1 = vtr(Vb + vof1 + 2048 * sp), h1 = vtr(Vb + vof1 + 2048 * sp + 1024);
        const bf16x8 v0 = (bf16x8){l0[0], l0[1], l0[2], l0[3], h0[0], h0[1], h0[2], h0[3]}, v1 = (bf16x8){l1[0], l1[1], l1[2], l1[3], h1[0], h1[1], h1[2], h1[3]};
        st.o0 = __builtin_amdgcn_mfma_f32_32x32x16_bf16(v0, pf[sp], st.o0, 0, 0, 0);
        st.o1 = __builtin_amdgcn_mfma_f32_32x32x16_bf16(v1, pf[sp], st.o1, 0, 0, 0);
    }
}

__device__ __forceinline__ void nsa_attn_phase(const Ctx& C) {
    LAS unsigned char* L = C.lds;
    LAS float* lut2 = (LAS float*)(L + LUT_OFF); LAS float* GE = (LAS float*)(L + GE_OFF); LAS float* SCp = (LAS float*)(L + SC_OFF); LAS unsigned* SELM = (LAS unsigned*)(L + SELM_OFF);
    const float* tab = C.in[IN_TAB];
    for (int i = C.tid; i < 16 * 129; i += NTHR) { const int h = i / 129, d = i % 129; lut2[i] = tab[t5_bucket(d) * 16 + h] * LOG2E; }
    __syncthreads();
    bf16* Q = (bf16*)(C.ws + NSA_Q); const bf16* KV = (const bf16*)(C.ws + NSA_KV); const bf16* Z = (const bf16*)(C.ws + NSA_Z); const float* GT = (const float*)(C.ws + NSA_GT);
    const bf16* KC = (const bf16*)(C.ws + NSA_KC); const bf16* VC = (const bf16*)(C.ws + NSA_VC);
    const int tid = C.tid, w = C.wave, lane = C.lane, c = lane & 31, hh = lane >> 5, r4 = w & 3, th = w >> 2, tok = 32 * th + c;
    unsigned kof[4];
#pragma unroll
    for (int ks = 0; ks < 4; ++ks) kof[ks] = (unsigned)(c * 128 + (((2 * ks + hh) ^ ((c >> 1) & 7)) << 4));
    const int gidx = lane >> 4, q4 = (lane >> 2) & 3, p4 = lane & 3, vb_ = (q4 >> 1) & 1;
    const unsigned vcom = (unsigned)((4 * hh + q4) * 128 + ((2 * (gidx & 1) + (p4 >> 1)) << 4) + (p4 & 1) * 8);
    const unsigned vof0 = vcom + 64u * (unsigned)(0 ^ vb_), vof1 = vcom + 64u * (unsigned)(1 ^ vb_);
    const int srow = tid >> 3, sch = tid & 7;
    const unsigned kst = (unsigned)(srow * 128 + ((sch ^ ((srow >> 1) & 7)) << 4)), vst = (unsigned)(8192 + srow * 128 + ((sch ^ (((srow >> 1) & 1) << 2)) << 4));
    for (int ui = C.vcu; ui < 1024; ui += C.G) {
        const int v = ui & 255, n = ui >> 8, k16 = v & 15;
        const int bg = (n < 2 ? 0 : 16) + (v >> 4), qt = n == 0 ? k16 : (n == 1 ? 31 - k16 : (n == 2 ? 15 - k16 : 16 + k16));
        const int b = bg >> 2, g = bg & 3, h = 4 * g + r4, t = 64 * qt + tok, row = b * S + t;
        bf16x8 qf[4];
#pragma unroll
        for (int ks = 0; ks < 4; ++ks) qf[ks] = *(const bf16x8*)(Q + (size_t)row * 1024 + h * 64 + 16 * ks + 8 * hh);
        const LAS float* lutp = lut2 + h * 129; const float lut128 = lutp[128];
        const bf16* KCb = KC + (size_t)bg * 128 * 64; const bf16* VCb = VC + (size_t)bg * 128 * 64;
        const bf16* KSb = KV + 2 * TS + (size_t)bg * 2048 * 64; const bf16* VSb = KV + 3 * TS + (size_t)bg * 2048 * 64;
        const bf16* KWb = KV + 4 * TS + (size_t)bg * 2048 * 64; const bf16* VWb = KV + 5 * TS + (size_t)bg * 2048 * 64;
        const int nslc = qt + 1, nwin = qt + 1 < 9 ? qt + 1 : 9, wlo = qt + 1 - nwin, ntile = 2 + nslc + nwin;
        const bool need_sel = qt >= 16;
        unsigned mysel = 0xffffffffu;
        Soft st; st.m = -1e30f; st.l = 0.f;
        f32x16 y0, y1;
#pragma unroll
        for (int i = 0; i < 16; ++i) { st.o0[i] = 0.f; st.o1[i] = 0.f; y0[i] = 0.f; y1[i] = 0.f; }
        v4u kreg = ((const v4u*)KCb)[tid], vreg = ((const v4u*)VCb)[tid];
        *(LAS v4u*)(L + kst) = kreg; *(LAS v4u*)(L + vst) = vreg;
        __syncthreads();
        float alpha1 = 1.f;
        for (int i = 0; i < ntile; ++i) {
            const int cb = (i & 1) * 16384, nb = ((i + 1) & 1) * 16384; const bool more = i + 1 < ntile;
            if (more) { const int i1 = i + 1; const bf16* kp; const bf16* vp;
                if (i1 < 2) { kp = KCb + 4096; vp = VCb + 4096; }
                else if (i1 < 2 + nslc) { kp = KSb + (size_t)(i1 - 2) * 4096; vp = VSb + (size_t)(i1 - 2) * 4096; }
                else { const int j = wlo + (i1 - 2 - nslc); kp = KWb + (size_t)j * 4096; vp = VWb + (size_t)j * 4096; }
                kreg = ((const v4u*)kp)[tid]; vreg = ((const v4u*)vp)[tid]; }
            int kind, base_d; bool sel = true; LAS float* ge = nullptr; int gj0 = 0;
            if (i < 2) { kind = 0; base_d = t - 31 - 1024 * i - 64 * hh; if (need_sel) { ge = GE + (r4 * 64 + tok) * 32; gj0 = 16 * i + hh; } }
            else if (i < 2 + nslc) { const int j = i - 2; sel = ((mysel >> j) & 1u) != 0u; base_d = 64 * (qt - j) + tok - 4 * hh; kind = (qt - j <= 2) ? 1 : 2; }
            else { const int j = wlo + (i - 2 - nslc); base_d = 64 * (qt - j) + tok - 4 * hh; kind = (qt - j <= 2) ? 1 : ((qt - j == 8) ? 3 : 2); }
            float al;
            attn_tile(st, L + cb, L + cb + 8192, qf, kof, vof0, vof1, kind, base_d, sel, lutp, lut128, ge, gj0, al);
            if (i == 1) alpha1 = al;
            const bool endb = (i == 1) || (i == 1 + nslc) || (i == ntile - 1);
            if (endb) {
                const int br = i == 1 ? 0 : (i == 1 + nslc ? 1 : 2);
                const float lf = xhalf_sum(st.l), inv = lf > 0.f ? 1.0f / lf : 0.f;
                if (br == 0 && need_sel && hh == 0) { SCp[(r4 * 64 + tok) * 2] = alpha1 * inv; SCp[(r4 * 64 + tok) * 2 + 1] = inv; }
                const float coef = GT[(size_t)row * 48 + br * 16 + h] * inv;
                const bf16* zp = Z + (size_t)row * 3072 + br * 1024 + h * 64 + 4 * hh;
#pragma unroll
                for (int i4 = 0; i4 < 4; ++i4) {
                    const v2u za = *(const v2u*)(zp + 8 * i4), zb = *(const v2u*)(zp + 32 + 8 * i4);
                    y0[4 * i4] += st.o0[4 * i4] * coef * bflo(za.x); y0[4 * i4 + 1] += st.o0[4 * i4 + 1] * coef * bfhi(za.x);
                    y0[4 * i4 + 2] += st.o0[4 * i4 + 2] * coef * bflo(za.y); y0[4 * i4 + 3] += st.o0[4 * i4 + 3] * coef * bfhi(za.y);
                    y1[4 * i4] += st.o1[4 * i4] * coef * bflo(zb.x); y1[4 * i4 + 1] += st.o1[4 * i4 + 1] * coef * bfhi(zb.x);
                    y1[4 * i4 + 2] += st.o1[4 * i4 + 2] * coef * bflo(zb.y); y1[4 * i4 + 3] += st.o1[4 * i4 + 3] * coef * bfhi(zb.y); }
                st.m = -1e30f; st.l = 0.f;
#pragma unroll
                for (int q = 0; q < 16; ++q) { st.o0[q] = 0.f; st.o1[q] = 0.f; }
            }
            if (more) { *(LAS v4u*)(L + nb + kst) = kreg; *(LAS v4u*)(L + nb + vst) = vreg; }
            __syncthreads();
            if (i == 1 && need_sel) {
                const LAS float* Gp = GE; const LAS float* Ep = GE + 8192;
#pragma unroll 1
                for (int k = 0; k < 4; ++k) {
                    const int tk = (tid >> 5) + 16 * k, j = tid & 31; float imp = 0.f;
#pragma unroll
                    for (int r = 0; r < 4; ++r) { const int ro = r * 64 + tk; const float f0 = SCp[ro * 2], f1 = SCp[ro * 2 + 1];
                        imp += Gp[ro * 32 + j] * (j < 16 ? f0 : f1);
                        if (j > 0) imp += Ep[ro * 32 + j - 1] * (j - 1 < 16 ? f0 : f1); }
                    const bool valid = j <= qt, forced = (j == 0) || (j == qt) || (j == qt - 1);
                    const float score = valid ? imp + (forced ? 1000.0f : 0.f) : -1e30f;
                    int rank = 0;
                    for (int i2 = 0; i2 < 32; ++i2) { const float si = __shfl(score, (lane & 32) | i2); rank += ((si > score) || (si == score && i2 < j)) ? 1 : 0; }
                    const unsigned long long bal = __ballot(rank < 16);
                    if ((lane & 31) == 0) SELM[tk] = (unsigned)(lane < 32 ? bal : (bal >> 32));
                }
                __syncthreads();
                mysel = SELM[tok];
            }
        }
        bf16* yp = Q + (size_t)row * 1024 + h * 64 + 4 * hh;
#pragma unroll
        for (int i4 = 0; i4 < 4; ++i4) {
            v2u a, bb; a.x = cvtpk(y0[4 * i4], y0[4 * i4 + 1]); a.y = cvtpk(y0[4 * i4 + 2], y0[4 * i4 + 3]); bb.x = cvtpk(y1[4 * i4], y1[4 * i4 + 1]); bb.y = cvtpk(y1[4 * i4 + 2], y1[4 * i4 + 3]);
            *(v2u*)(yp + 8 * i4) = a; *(v2u*)(yp + 32 + 8 * i4) = bb; }
    }
}
}
namespace ret {
using nsa::bf16x8; using nsa::s16x4; using nsa::f32x16; using nsa::vtr; using nsa::cvtpk; using nsa::koff; using nsa::xhalf_sum;
constexpr int PROW = 1040;
constexpr int P_OFF = 0, VT_OFF = 66560;
constexpr int A_BUF = 40960;
__device__ __forceinline__ v4u scale8(const v4u x, const float f) { v4u o; o.x = cvtpk(bflo(x.x) * f, bfhi(x.x) * f); o.y = cvtpk(bflo(x.y) * f, bfhi(x.y) * f); o.z = cvtpk(bflo(x.z) * f, bfhi(x.z) * f); o.w = cvtpk(bflo(x.w) * f, bfhi(x.w) * f); return o; }
__device__ __forceinline__ bf16x8 mk8(const s16x4 lo, const s16x4 hi) { return (bf16x8){lo[0], lo[1], lo[2], lo[3], hi[0], hi[1], hi[2], hi[3]}; }

__device__ __forceinline__ void ret_pass_a(const Ctx& C) {
    LAS unsigned char* L = C.lds;
    const bf16* Kr = (const bf16*)(C.ws + RET_K); const bf16* Vr = (const bf16*)(C.ws + RET_V); bf16* ST = (bf16*)(C.ws + WS_HB);
    const int tid = C.tid, w = C.wave, lane = C.lane, cl = lane & 31, hh = lane >> 5;
    const int gidx = lane >> 4, q4 = (lane >> 2) & 3, p4 = lane & 3, vb_ = (q4 >> 1) & 1;
    const unsigned vcom = (unsigned)((4 * hh + q4) * 128 + ((2 * (gidx & 1) + (p4 >> 1)) << 4) + (p4 & 1) * 8);
    const unsigned vof0 = 32768u + vcom + 64u * (unsigned)(0 ^ vb_), vof1 = 32768u + vcom + 64u * (unsigned)(1 ^ vb_);
    const unsigned kof = (unsigned)((4 * hh + q4) * 512 + ((w ^ q4) << 6) + 32 * (gidx & 1) + 8 * p4);
    for (int u = C.vcu; u < 256; u += C.G) {
        const int bh = u >> 3, sl = u & 7, b = bh >> 2, h = bh & 3;
        const float lg = __log2f(1.0f - exp2f(-5.0f - (float)h));
        const bf16* kbase = Kr + (size_t)(b * S) * 1024 + h * 256; const bf16* vbase = Vr + (size_t)(b * S) * 2048 + h * 512 + 64 * sl;
        f32x16 a0, a1;
#pragma unroll
        for (int i = 0; i < 16; ++i) { a0[i] = 0.f; a1[i] = 0.f; }
        v4u kr[4], vr;
#define RA_LOAD(T) do { const int tb_ = 64 * (T); _Pragma("unroll") for (int k = 0; k < 4; ++k) { const int p = tid + 512 * k, key = p >> 5, pc = p & 31; kr[k] = *(const v4u*)(kbase + (size_t)(tb_ + key) * 1024 + pc * 8); } \
        { const int key = tid >> 3, ch = tid & 7; vr = scale8(*(const v4u*)(vbase + (size_t)(tb_ + key) * 2048 + ch * 8), __builtin_amdgcn_exp2f((float)(511 - ((tb_ + key) & 511)) * lg)); } } while (0)
#define RA_STORE(BUF) do { _Pragma("unroll") for (int k = 0; k < 4; ++k) { const int p = tid + 512 * k, key = p >> 5, pc = p & 31; *(LAS v4u*)(L + (BUF) + key * 512 + ((((pc >> 2) ^ (key & 3))) << 6) + ((pc & 3) << 4)) = kr[k]; } \
        { const int key = tid >> 3, ch = tid & 7; *(LAS v4u*)(L + (BUF) + 32768 + key * 128 + ((ch ^ (((key >> 1) & 1) << 2)) << 4)) = vr; } } while (0)
        RA_LOAD(0); RA_STORE(0);
        __syncthreads();
        for (int i = 0; i < 24; ++i) {
            const int cb = (i & 1) * A_BUF, nb = ((i + 1) & 1) * A_BUF;
            if (i + 1 < 24) RA_LOAD(i + 1);
#pragma unroll
            for (int sp = 0; sp < 4; ++sp) {
                const bf16x8 ka = mk8(vtr(L + cb + kof + 8192 * sp), vtr(L + cb + kof + 8192 * sp + 4096));
                const bf16x8 v0 = mk8(vtr(L + cb + vof0 + 2048 * sp), vtr(L + cb + vof0 + 2048 * sp + 1024)), v1 = mk8(vtr(L + cb + vof1 + 2048 * sp), vtr(L + cb + vof1 + 2048 * sp + 1024));
                a0 = __builtin_amdgcn_mfma_f32_32x32x16_bf16(ka, v0, a0, 0, 0, 0);
                a1 = __builtin_amdgcn_mfma_f32_32x32x16_bf16(ka, v1, a1, 0, 0, 0);
            }
            if (i + 1 < 24) RA_STORE(nb);
            __syncthreads();
            if ((i & 7) == 7) {
                const int cc = i >> 3;
                bf16* st0 = ST + ((size_t)((bh * 3 + cc) * 512 + 64 * sl + cl)) * 256 + 32 * w + 4 * hh;
#pragma unroll
                for (int i4 = 0; i4 < 4; ++i4) {
                    v2u x, y; x.x = cvtpk(a0[4 * i4], a0[4 * i4 + 1]); x.y = cvtpk(a0[4 * i4 + 2], a0[4 * i4 + 3]); y.x = cvtpk(a1[4 * i4], a1[4 * i4 + 1]); y.y = cvtpk(a1[4 * i4 + 2], a1[4 * i4 + 3]);
                    *(v2u*)(st0 + 8 * i4) = x; *(v2u*)(st0 + (size_t)32 * 256 + 8 * i4) = y; }
                const float dec = __builtin_amdgcn_exp2f(512.0f * lg);
#pragma unroll
                for (int q = 0; q < 16; ++q) { a0[q] *= dec; a1[q] *= dec; }
            }
        }
#undef RA_LOAD
#undef RA_STORE
    }
}

__device__ __forceinline__ void ret_pass_c(const Ctx& C, int slot) {
    LAS unsigned char* L = C.lds;
    const bf16* Qr = (const bf16*)(C.ws + RET_Q); const bf16* Kr = (const bf16*)(C.ws + RET_K); const bf16* Vr = (const bf16*)(C.ws + RET_V); bf16* Zr = (bf16*)(C.ws + RET_Z);
    const bf16* ST = (const bf16*)(C.ws + WS_HB); const float* gn = C.in[IN_GN] + (size_t)slot * 2048;
    const int tid = C.tid, w = C.wave, lane = C.lane, cl = lane & 31, hh = lane >> 5;
    const int gidx = lane >> 4, q4 = (lane >> 2) & 3, p4 = lane & 3, vb_ = (q4 >> 1) & 1;
    const unsigned vcom = (unsigned)(w * 4096 + (8 * hh + q4) * 128 + ((2 * (gidx & 1) + (p4 >> 1)) << 4) + (p4 & 1) * 8);
    const unsigned vof0 = VT_OFF + vcom + 64u * (unsigned)(0 ^ vb_), vof1 = VT_OFF + vcom + 64u * (unsigned)(1 ^ vb_);
    for (int ui = C.vcu; ui < 1024; ui += C.G) {
        const int v = ui & 255, n = ui >> 8, bh = v >> 3, k8 = v & 7, c = n, k3 = (k8 + 3) & 7;
        const int rb8 = n == 0 ? k8 : (n == 1 ? 7 - k8 : (n == 2 ? k3 : 7 - k3));
        const int b = bh >> 2, h = bh & 3;
        const float lg = __log2f(1.0f - exp2f(-5.0f - (float)h));
        const size_t tok0 = (size_t)b * S + 512 * c;
        const int q0 = 64 * rb8;
        {   const int qh = w & 1, iq = q0 + 32 * qh + cl;
            bf16x8 qf[16];
            const bf16* qp = Qr + (tok0 + iq) * 1024 + h * 256 + 8 * hh;
#pragma unroll
            for (int ks = 0; ks < 16; ++ks) qf[ks] = *(const bf16x8*)(qp + 16 * ks);
            float colf[16];
#pragma unroll
            for (int i = 0; i < 16; ++i) colf[i] = __builtin_amdgcn_exp2f(-lg * (float)koff(i));
            for (int kt = w >> 1; kt < 2 * (rb8 + 1); kt += 4) {
                const int kb = 32 * kt;
                const bf16* kp = Kr + (tok0 + kb + cl) * 1024 + h * 256 + 8 * hh;
                f32x16 s;
#pragma unroll
                for (int i = 0; i < 16; ++i) s[i] = 0.f;
#pragma unroll
                for (int ks = 0; ks < 16; ++ks) { const bf16x8 ka = *(const bf16x8*)(kp + 16 * ks); s = __builtin_amdgcn_mfma_f32_32x32x16_bf16(ka, qf[ks], s, 0, 0, 0); }
                const int d0 = iq - kb - 4 * hh; const float rf = __builtin_amdgcn_exp2f(lg * (float)d0);
                LAS unsigned char* pw = L + P_OFF + (32 * qh + cl) * PROW + (kb + 4 * hh) * 2;
#pragma unroll
                for (int i4 = 0; i4 < 4; ++i4) {
                    float p[4];
#pragma unroll
                    for (int e = 0; e < 4; ++e) { const int i = 4 * i4 + e; p[e] = (d0 - koff(i) >= 0) ? s[i] * rf * colf[i] : 0.f; }
                    v2u x; x.x = cvtpk(p[0], p[1]); x.y = cvtpk(p[2], p[3]);
                    *(LAS v2u*)(pw + 16 * i4) = x; }
            }
        }
        f32x16 acc[2][2];
#pragma unroll
        for (int a = 0; a < 2; ++a)
#pragma unroll
            for (int bq = 0; bq < 2; ++bq)
#pragma unroll
                for (int i = 0; i < 16; ++i) acc[a][bq][i] = 0.f;
        const int nvt = 2 * (rb8 + 1);
        const bf16* vsrc = Vr + tok0 * 2048 + h * 512;
        v4u vr[4];
#define RC_LOAD(T) do { _Pragma("unroll") for (int k = 0; k < 4; ++k) { const int p = tid + 512 * k, key = p >> 6, pc = p & 63; vr[k] = *(const v4u*)(vsrc + (size_t)(32 * (T) + key) * 2048 + pc * 8); } } while (0)
#define RC_STORE(BUF) do { _Pragma("unroll") for (int k = 0; k < 4; ++k) { const int p = tid + 512 * k, key = p >> 6, pc = p & 63; \
            *(LAS v4u*)(L + VT_OFF + (BUF) + (pc >> 3) * 4096 + key * 128 + (((pc & 7) ^ (((key >> 1) & 1) << 2)) << 4)) = vr[k]; } } while (0)
        RC_LOAD(0);
        if (c > 0) {
            const bf16* sp0 = ST + ((size_t)((bh * 3 + (c - 1)) * 512 + 64 * w + cl)) * 256 + 8 * hh;
            const bf16* qp0 = Qr + (tok0 + q0 + cl) * 1024 + h * 256 + 8 * hh;
#pragma unroll 4
            for (int ks = 0; ks < 16; ++ks) {
                const bf16x8 s0 = *(const bf16x8*)(sp0 + 16 * ks), s1 = *(const bf16x8*)(sp0 + (size_t)32 * 256 + 16 * ks);
                const bf16x8 b0 = *(const bf16x8*)(qp0 + 16 * ks), b1 = *(const bf16x8*)(qp0 + (size_t)32 * 1024 + 16 * ks);
                acc[0][0] = __builtin_amdgcn_mfma_f32_32x32x16_bf16(s0, b0, acc[0][0], 0, 0, 0); acc[0][1] = __builtin_amdgcn_mfma_f32_32x32x16_bf16(s0, b1, acc[0][1], 0, 0, 0);
                acc[1][0] = __builtin_amdgcn_mfma_f32_32x32x16_bf16(s1, b0, acc[1][0], 0, 0, 0); acc[1][1] = __builtin_amdgcn_mfma_f32_32x32x16_bf16(s1, b1, acc[1][1], 0, 0, 0);
            }
            const float x0 = __builtin_amdgcn_exp2f(lg * (float)(q0 + cl + 1)), x1 = __builtin_amdgcn_exp2f(lg * (float)(q0 + 32 + cl + 1));
#pragma unroll
            for (int i = 0; i < 16; ++i) { acc[0][0][i] *= x0; acc[1][0][i] *= x0; acc[0][1][i] *= x1; acc[1][1][i] *= x1; }
        }
        RC_STORE(0);
        __syncthreads();
        for (int vt = 0; vt < nvt; ++vt) {
            const unsigned cb = (unsigned)(vt & 1) * 32768u, nb = (unsigned)((vt + 1) & 1) * 32768u;
            if (vt + 1 < nvt) RC_LOAD(vt + 1);
#pragma unroll
            for (int sp = 0; sp < 2; ++sp) {
                const bf16x8 v0 = mk8(vtr(L + cb + vof0 + 2048 * sp), vtr(L + cb + vof0 + 2048 * sp + 512)), v1 = mk8(vtr(L + cb + vof1 + 2048 * sp), vtr(L + cb + vof1 + 2048 * sp + 512));
                const LAS unsigned char* pp = L + P_OFF + cl * PROW + (32 * vt + 16 * sp + 8 * hh) * 2;
                const bf16x8 p0 = *(const LAS bf16x8*)(pp), p1 = *(const LAS bf16x8*)(pp + 32 * PROW);
                acc[0][0] = __builtin_amdgcn_mfma_f32_32x32x16_bf16(v0, p0, acc[0][0], 0, 0, 0); acc[0][1] = __builtin_amdgcn_mfma_f32_32x32x16_bf16(v0, p1, acc[0][1], 0, 0, 0);
                acc[1][0] = __builtin_amdgcn_mfma_f32_32x32x16_bf16(v1, p0, acc[1][0], 0, 0, 0); acc[1][1] = __builtin_amdgcn_mfma_f32_32x32x16_bf16(v1, p1, acc[1][1], 0, 0, 0);
            }
            if (vt + 1 < nvt) RC_STORE(nb);
            __syncthreads();
        }
#undef RC_LOAD
#undef RC_STORE
        LAS float* red = (LAS float*)(L + P_OFF);
#pragma unroll
        for (int bq = 0; bq < 2; ++bq) { float s1 = 0.f, s2 = 0.f;
#pragma unroll
            for (int i = 0; i < 16; ++i) { const float x = acc[0][bq][i], y = acc[1][bq][i]; s1 += x + y; s2 += x * x + y * y; }
            s1 = xhalf_sum(s1); s2 = xhalf_sum(s2);
            if (hh == 0) { red[(w * 64 + 32 * bq + cl) * 2] = s1; red[(w * 64 + 32 * bq + cl) * 2 + 1] = s2; } }
        __syncthreads();
#pragma unroll
        for (int bq = 0; bq < 2; ++bq) { float s1 = 0.f, s2 = 0.f;
#pragma unroll
            for (int ww = 0; ww < 8; ++ww) { s1 += red[(ww * 64 + 32 * bq + cl) * 2]; s2 += red[(ww * 64 + 32 * bq + cl) * 2 + 1]; }
            const float mu = s1 * (1.0f / 512.0f), var = fmaxf(s2 * (1.0f / 512.0f) - mu * mu, 0.f), rstd = rsqrtf(var + GN_EPS);
            bf16* zrow = Zr + (tok0 + q0 + 32 * bq + cl) * 2048 + h * 512 + 64 * w + 4 * hh;
            const float* grow = gn + h * 512 + 64 * w + 4 * hh;
#pragma unroll
            for (int a = 0; a < 2; ++a)
#pragma unroll
                for (int i4 = 0; i4 < 4; ++i4) {
                    const v2u z = *(const v2u*)(zrow + 32 * a + 8 * i4); const f32x4 gg = *(const f32x4*)(grow + 32 * a + 8 * i4);
                    const float o0 = (acc[a][bq][4 * i4] - mu) * rstd * gg.x * bflo(z.x), o1 = (acc[a][bq][4 * i4 + 1] - mu) * rstd * gg.y * bfhi(z.x);
                    const float o2 = (acc[a][bq][4 * i4 + 2] - mu) * rstd * gg.z * bflo(z.y), o3 = (acc[a][bq][4 * i4 + 3] - mu) * rstd * gg.w * bfhi(z.y);
                    v2u o; o.x = cvtpk(o0, o1); o.y = cvtpk(o2, o3); *(v2u*)(zrow + 32 * a + 8 * i4) = o; }
        }
        __syncthreads();
    }
}
}
namespace cmp {
using nsa::bf16x8; using nsa::f32x16; using nsa::cvtpk; using nsa::koff;
constexpr size_t WS_W1T = 20 * MiB;
constexpr size_t WS_W2T = 3 * MiB;
constexpr size_t WS_POSB = 3 * MiB + 256 * 1024;
constexpr int HROW = 264;
__device__ __forceinline__ void posbias(const Ctx& C) {
    LAS float* red = (LAS float*)C.lds;
    for (int u = C.vcu; u < 16; u += C.G) {
        const int slot = u >> 3, kv = (u >> 2) & 1, cg = u & 3, j = 64 * cg + C.lane;
        const float* pos = C.in[kv ? IN_VPOS : IN_KPOS] + (size_t)slot * 2048; const float* w1 = C.in[kv ? IN_VW1 : IN_KW1] + (size_t)slot * 2048 * 256;
        float a = 0.f;
        for (int k = 256 * C.wave; k < 256 * C.wave + 256; ++k) a += pos[k] * w1[(size_t)k * 256 + j];
        red[C.wave * 64 + C.lane] = a;
        __syncthreads();
        if (C.wave == 0) { float s = 0.f;
#pragma unroll
            for (int ww = 0; ww < 8; ++ww) s += red[ww * 64 + C.lane];
            ((float*)(C.ws + WS_POSB))[(slot * 2 + kv) * 256 + j] = s; }
        __syncthreads();
    }
}
__device__ __forceinline__ void compress_phase(const Ctx& C, int slot) {
    LAS unsigned char* L = C.lds; LAS unsigned short* hid = (LAS unsigned short*)L;
    const int w = C.wave, lane = C.lane, cl = lane & 31, hh = lane >> 5;
    for (int u = C.vcu; u < 256; u += C.G) {
        const int kv = u >> 7, rb = u & 127;
        const bf16* X = (const bf16*)(C.ws + NSA_KV) + (size_t)kv * (16384 * 256);
        const bf16* W1T = (const bf16*)(C.ws + WS_W1T) + (size_t)(slot * 2 + kv) * 256 * 2048;
        const bf16* W2T = (const bf16*)(C.ws + WS_W2T) + (size_t)(slot * 2 + kv) * 64 * 256;
        const float pb = ((const float*)(C.ws + WS_POSB))[(slot * 2 + kv) * 256 + 32 * w + cl];
        const bf16* ap = X + (size_t)(32 * rb + cl) * 1024 + 8 * hh; const bf16* bp = W1T + (size_t)(32 * w + cl) * 2048 + 8 * hh;
        f32x16 acc;
#pragma unroll
        for (int i = 0; i < 16; ++i) acc[i] = 0.f;
#pragma unroll 8
        for (int ks = 0; ks < 128; ++ks) { const bf16x8 a = *(const bf16x8*)(ap + 16 * ks), b = *(const bf16x8*)(bp + 16 * ks); acc = __builtin_amdgcn_mfma_f32_32x32x16_bf16(a, b, acc, 0, 0, 0); }
#pragma unroll
        for (int i = 0; i < 16; ++i) { const float x = acc[i] + pb; const float s = x / (1.0f + __expf(-x)); hid[(koff(i) + 4 * hh) * HROW + 32 * w + cl] = (unsigned short)(cvtpk(s, 0.f) & 0xffffu); }
        __syncthreads();
        if (w < 2) {
            f32x16 o;
#pragma unroll
            for (int i = 0; i < 16; ++i) o[i] = 0.f;
            const bf16* b2 = W2T + (size_t)(32 * w + cl) * 256 + 8 * hh;
#pragma unroll
            for (int ks = 0; ks < 16; ++ks) { const bf16x8 a = *(const LAS bf16x8*)(L + (cl * HROW + 16 * ks + 8 * hh) * 2), b = *(const bf16x8*)(b2 + 16 * ks); o = __builtin_amdgcn_mfma_f32_32x32x16_bf16(a, b, o, 0, 0, 0); }
            bf16* dst = (bf16*)(C.ws + (kv ? NSA_VC : NSA_KC)) + (size_t)(32 * rb) * 64 + 32 * w + cl;
#pragma unroll
            for (int i = 0; i < 16; ++i) { const int r = koff(i) + 4 * hh; const bool dummy = ((32 * rb + r) & 127) == 127; dst[(size_t)r * 64] = dummy ? (bf16)0 : (bf16)(cvtpk(o[i], 0.f) & 0xffffu); }
        }
        __syncthreads();
    }
}
}
constexpr int PH_PER_PAIR = 10, N_PHASES = 1 + 2 * PH_PER_PAIR;
struct Args { const float* in[15]; float* out; unsigned char* ws; int ph_lo, ph_hi; };
#define IN(k) (lo <= (k) && (k) < hi)
#define SEAM(k) do { if (IN(k) && IN((k) + 1)) xcd_barrier(bar); } while (0)
template <int p> __device__ __forceinline__ void layer_pair(const Ctx& C, const XcdBarrier& bar, const int lo, const int hi) {
    unsigned char* ws = C.ws;
    float* rss_base = (float*)(ws + WS_CTL) + CW_RSS;
    bf16* WIN = (bf16*)(ws + WS_WIN); bf16* WOUT = (bf16*)(ws + WS_WOUT); bf16* HB = (bf16*)(ws + WS_HB);
        const int pb = 1 + PH_PER_PAIR * p, L0 = 2 * p, L1 = 2 * p + 1;
        if (IN(pb + 0)) {
            pg8::Gemm g{HB, WIN, M, NSA_NP, 1024}; pg8::StaticOrder So; So.init(M, NSA_NP, C.G, (int)blockIdx.x);
            pg8::EpiNsaProj E{rss_base + (size_t)L0 * 16384, (bf16*)(ws + NSA_Q), (bf16*)(ws + NSA_KV), (bf16*)(ws + NSA_Z), (float*)(ws + NSA_GT)};
            pg8::gemm_phase<pg8::EpiNsaProj, pg8::StaticOrder, true, true>(C.lds + RING_OFF, g, So, E);
        }
        SEAM(pb + 0);
        if (IN(pb + 1)) {
            convert_weights<0>(C, C.in[IN_NWOUT] + (size_t)p * 1024 * 1024, 1024, 1024, 1024, nullptr, WOUT);
            convert_weights<0>(C, C.in[IN_RWIN] + (size_t)p * 1024 * 6144, 1024, 6144, RET_NP, C.in[IN_PRE] + (size_t)L1 * D, WIN);
            __syncthreads();
            cmp::compress_phase(C, p);
        }
        SEAM(pb + 1);
        if (IN(pb + 2)) nsa::nsa_attn_phase(C);
        SEAM(pb + 2);
        if (IN(pb + 3)) {
            pg8::Gemm g{(const bf16*)(ws + NSA_Q), WOUT, M, 1024, 1024}; pg8::StaticOrder So; So.init(M, 1024, C.G, (int)blockIdx.x);
            pg8::EpiF32 E{(float*)(ws + NSA_YO), 1024};
            pg8::gemm_phase<pg8::EpiF32, pg8::StaticOrder, true, true>(C.lds + RING_OFF, g, So, E);
        }
        SEAM(pb + 3);
        if (IN(pb + 4)) naive_norm_res(C, L0, (const float*)(ws + NSA_YO));
        SEAM(pb + 4);
        if (IN(pb + 5)) {
            pg8::Gemm g{HB, WIN, M, RET_NP, 1024}; pg8::StaticOrder So; So.init(M, RET_NP, C.G, (int)blockIdx.x);
            pg8::EpiRetProj E{rss_base + (size_t)L1 * 16384, (const float*)(ws + WS_COS), (const float*)(ws + WS_SIN), (bf16*)(ws + RET_Q), (bf16*)(ws + RET_K), (bf16*)(ws + RET_V), (bf16*)(ws + RET_Z)};
            pg8::gemm_phase<pg8::EpiRetProj, pg8::StaticOrder, true, true>(C.lds + RING_OFF, g, So, E);
        }
        SEAM(pb + 5);
        if (IN(pb + 6)) {
            convert_weights<0>(C, C.in[IN_RWOUT] + (size_t)p * 2048 * 1024, 2048, 1024, 1024, nullptr, WOUT);
            if (p == 0) convert_weights<1>(C, C.in[IN_NWIN] + (size_t)1 * 1024 * 5680, 1024, 5680, NSA_NP, C.in[IN_PRE] + (size_t)2 * D, WIN);
            __syncthreads();
            ret::ret_pass_a(C);
        }
        SEAM(pb + 6);
        if (IN(pb + 7)) ret::ret_pass_c(C, p);
        SEAM(pb + 7);
        if (IN(pb + 8)) {
            pg8::Gemm g{(const bf16*)(ws + RET_Z), WOUT, M, 1024, 2048}; pg8::StaticOrder So; So.init(M, 1024, C.G, (int)blockIdx.x);
            pg8::EpiF32 E{(float*)(ws + RET_YO), 1024};
            pg8::gemm_phase<pg8::EpiF32, pg8::StaticOrder, true, true>(C.lds + RING_OFF, g, So, E);
        }
        SEAM(pb + 8);
        if (IN(pb + 9)) naive_norm_res(C, L1, (const float*)(ws + RET_YO));
        SEAM(pb + 9);
    }
__global__ void __launch_bounds__(NTHR, 2) hybrid_fwd(Args args) {
    extern __shared__ __attribute__((aligned(16))) unsigned char lds[];
    Ctx C;
    C.lds = (LAS unsigned char*)lds;
    C.tid = threadIdx.x; C.lane = C.tid & 63; C.wave = __builtin_amdgcn_readfirstlane(C.tid >> 6);
    C.G = gridDim.x; { const int bx = blockIdx.x; C.vcu = (C.G % 8 == 0) ? (bx % 8) * (C.G / 8) + bx / 8 : bx; }
#pragma unroll
    for (int i = 0; i < 15; ++i) C.in[i] = args.in[i];
    C.out = args.out; C.ws = args.ws;
    unsigned char* ws = args.ws;
    gu32* ctl = (gu32*)(ws + WS_CTL);
    volatile LAS unsigned* MISC = (volatile LAS unsigned*)(C.lds + MISC_OFF);
    for (int u = C.tid; u < (LDS_BYTES - LDSCTL_OFF) / 4; u += NTHR) ((LAS unsigned*)(C.lds + LDSCTL_OFF))[u] = 0u;
    __syncthreads();
    XcdBarrier bar = xcd_barrier_post((unsigned*)(ctl + CW_BAR), MISC + 8);
    const int lo = args.ph_lo, hi = args.ph_hi;
    float* rss_base = (float*)(ws + WS_CTL) + CW_RSS;
    bf16* WIN = (bf16*)(ws + WS_WIN); bf16* WOUT = (bf16*)(ws + WS_WOUT); bf16* HB = (bf16*)(ws + WS_HB);

    if (IN(0)) {
        convert_weights<1>(C, C.in[IN_NWIN], 1024, 5680, NSA_NP, C.in[IN_PRE], WIN);
        for (int sk = 0; sk < 4; ++sk) {
            convert_weights<0>(C, C.in[(sk & 1) ? IN_VW1 : IN_KW1] + (size_t)(sk >> 1) * 2048 * 256, 2048, 256, 256, nullptr, (bf16*)(ws + cmp::WS_W1T) + (size_t)sk * 256 * 2048);
            convert_weights<0>(C, C.in[(sk & 1) ? IN_VW2 : IN_KW2] + (size_t)(sk >> 1) * 256 * 64, 256, 64, 64, nullptr, (bf16*)(ws + cmp::WS_W2T) + (size_t)sk * 64 * 256); }
        p0_rows(C); p0_tables(C);
        __syncthreads();
        cmp::posbias(C);
    }
    SEAM(0);
    layer_pair<0>(C, bar, lo, hi);
    layer_pair<1>(C, bar, lo, hi);
#undef IN
#undef SEAM
}

#ifndef N_LAUNCH_MODE
#define N_LAUNCH_MODE 1
#endif
extern "C" void kernel_launch(void* const* d_in, const int* in_sizes, int n_in, void* d_out, int out_size, void* d_ws, size_t ws_size, hipStream_t stream) {
    static int grid = 0;
    if (grid == 0) {
        if (n_in != 15 || out_size != M * D || ws_size < WS_END) { fprintf(stderr, "kernel_launch: unexpected problem shape (n_in %d, out %d, ws %zu)\n", n_in, out_size, ws_size); grid = -1; return; }
        int dev = 0, cus = 0, per_cu = 0;
        if (hipGetDevice(&dev) != hipSuccess || hipDeviceGetAttribute(&cus, hipDeviceAttributeMultiprocessorCount, dev) != hipSuccess) { grid = -1; return; }
        if (hipFuncSetAttribute((const void*)hybrid_fwd, hipFuncAttributeMaxDynamicSharedMemorySize, LDS_BYTES) != hipSuccess) { fprintf(stderr, "kernel_launch: hipFuncSetAttribute failed\n"); grid = -1; return; }
        if (hipOccupancyMaxActiveBlocksPerMultiprocessor(&per_cu, (const void*)hybrid_fwd, NTHR, LDS_BYTES) != hipSuccess || per_cu < 1) { fprintf(stderr, "kernel_launch: occupancy query reports %d blocks per CU\n", per_cu); }
        (void)hipGetLastError();
        grid = cus;
    }
    if (grid < 0) return;
    if (hipMemsetAsync((char*)d_ws + WS_CTL, 0, CTL_ZERO_BYTES, stream) != hipSuccess) return;
    Args a{};
    for (int i = 0; i < 15; ++i) a.in[i] = (const float*)d_in[i];
    a.out = (float*)d_out; a.ws = (unsigned char*)d_ws;
#if N_LAUNCH_MODE == 1
    a.ph_lo = 0; a.ph_hi = N_PHASES;
    hipLaunchKernelGGL(hybrid_fwd, dim3(grid), dim3(NTHR), LDS_BYTES, stream, a);
#else
    for (int k = 0; k < N_PHASES; ++k) { a.ph_lo = k; a.ph_hi = k + 1; hipLaunchKernelGGL(hybrid_fwd, dim3(grid), dim3(NTHR), LDS_BYTES, stream, a); }
#endif
}
```
